# Optimizing an MI355X kernel written in HIP

```python
import jax, jax.numpy as jnp
from jax import lax
import numpy as np

D_MODEL = 1024
BATCH = 2
SEQ = 8192
DEPTH = 2

N_HEADS = 16
HEAD_DIM = D_MODEL // N_HEADS
D_FF = -(-8 * D_MODEL // (3 * 256)) * 256
BLOCK_Q = 128
N_A = DEPTH // 2
N_B = DEPTH - N_A
EPS = 1e-6

kernel_name = "yoco_stickbreak_fox_adaln"


def rms_norm(x, g):
    xf = x.astype(jnp.float32)
    y = xf * lax.rsqrt(jnp.mean(xf * xf, axis=-1, keepdims=True) + EPS)
    return (y * g.astype(jnp.float32)).astype(x.dtype)


def modulate(h, shift, scale):
    return h * (1.0 + scale[:, None, :]) + shift[:, None, :]


def split_heads(t):
    b, s, _ = t.shape
    return t.reshape(b, s, N_HEADS, HEAD_DIM).transpose(0, 2, 1, 3)


def merge_heads(t):
    b, h, s, d = t.shape
    return t.transpose(0, 2, 1, 3).reshape(b, s, h * d)


def to_blocks(t):
    b, h, s = t.shape[:3]
    t = t.reshape((b, h, s // BLOCK_Q, BLOCK_Q) + t.shape[3:])
    return jnp.moveaxis(t, 2, 0)


def from_blocks(t):
    nb, b, h, bq, d = t.shape
    return jnp.moveaxis(t, 0, 2).reshape(b, h, nb * bq, d)


def stick_breaking_attention(q, k, v):
    s_len = q.shape[2]
    scale = HEAD_DIM ** -0.5
    kpos = jnp.arange(s_len)

    def block(args):
        qb, start = args
        z = jnp.einsum('bhqd,bhkd->bhqk', qb, k).astype(jnp.float32) * scale
        qpos = start + jnp.arange(BLOCK_Q)
        mask = kpos[None, :] < qpos[:, None]
        log_1m = jnp.where(mask, jax.nn.log_sigmoid(-z), 0.0)
        log_rest = lax.cumsum(log_1m, axis=3, reverse=True) - log_1m
        a = jnp.where(mask, jnp.exp(jax.nn.log_sigmoid(z) + log_rest), 0.0)
        return jnp.einsum('bhqk,bhkd->bhqd', a.astype(v.dtype), v)

    starts = jnp.arange(s_len // BLOCK_Q) * BLOCK_Q
    return from_blocks(lax.map(block, (to_blocks(q), starts)))


def forgetting_attention(q, k, v, fcum):
    s_len = q.shape[2]
    scale = HEAD_DIM ** -0.5
    kpos = jnp.arange(s_len)

    def block(args):
        qb, fq, start = args
        logit = jnp.einsum('bhqd,bhkd->bhqk', qb, k).astype(jnp.float32) * scale
        logit = logit + fq[..., :, None] - fcum[:, :, None, :]
        qpos = start + jnp.arange(BLOCK_Q)
        mask = kpos[None, :] <= qpos[:, None]
        p = jax.nn.softmax(jnp.where(mask, logit, -jnp.inf), axis=-1)
        return jnp.einsum('bhqk,bhkd->bhqd', p.astype(v.dtype), v)

    starts = jnp.arange(s_len // BLOCK_Q) * BLOCK_Q
    return from_blocks(lax.map(block, (to_blocks(q), to_blocks(fcum), starts)))


def swiglu(h, w_in, w_down):
    g, u = jnp.split(h @ w_in, 2, axis=-1)
    return (jax.nn.silu(g) * u) @ w_down


def setup_inputs(seed: int = 0) -> dict:
    key = jax.random.key(seed)
    ks = jax.random.split(key, 20)
    D, H, F, dh = D_MODEL, N_HEADS, D_FF, HEAD_DIM
    f32 = jnp.float32

    def w(k, shape, fan_in, mult=1.0):
        return jax.random.normal(k, shape, f32) * (mult * fan_in ** -0.5)

    def gain(k, shape):
        return 1.0 + 0.02 * jax.random.normal(k, shape, f32)

    return {
        "x": jax.random.normal(ks[0], (BATCH, SEQ, D), f32),
        "c": jax.random.normal(ks[1], (BATCH, D), f32),
        "ada_w": w(ks[2], (DEPTH, D, 6 * D), D, 0.5),
        "ada_b": 0.02 * jax.random.normal(ks[3], (DEPTH, 6 * D), f32),
        "norm_attn_g": gain(ks[4], (DEPTH, D)),
        "norm_ffn_g": gain(ks[5], (DEPTH, D)),
        "w_ffn_in": w(ks[6], (DEPTH, D, 2 * F), D),
        "w_ffn_down": w(ks[7], (DEPTH, F, D), F),
        "sb_w_qkv": w(ks[8], (N_A, D, 3 * D), D),
        "sb_w_o": w(ks[9], (N_A, D, D), D),
        "kv_ada_w": w(ks[10], (D, 2 * D), D, 0.5),
        "kv_ada_b": 0.02 * jax.random.normal(ks[11], (2 * D,), f32),
        "kv_norm_g": gain(ks[12], (D,)),
        "w_kvf": w(ks[13], (D, 2 * D + H), D),
        "b_f": jax.random.uniform(ks[14], (H,), f32, 1.0, 4.0),
        "k_norm_g": gain(ks[15], (dh,)),
        "fox_w_q": w(ks[16], (N_B, D, D), D),
        "q_norm_g": gain(ks[17], (N_B, dh)),
        "fox_w_o": w(ks[18], (N_B, D, D), D),
    }


def reference(x, c, ada_w, ada_b, norm_attn_g, norm_ffn_g, w_ffn_in, w_ffn_down,
              sb_w_qkv, sb_w_o, kv_ada_w, kv_ada_b, kv_norm_g, w_kvf, b_f,
              k_norm_g, fox_w_q, q_norm_g, fox_w_o):
    D = D_MODEL
    c_act = jax.nn.silu(c.astype(jnp.float32)).astype(x.dtype)
    k_sh = v_sh = fcum = None
    for layer in range(DEPTH):
        mod = c_act @ ada_w[layer] + ada_b[layer]
        sh_a, sc_a, g_a, sh_f, sc_f, g_f = jnp.split(mod, 6, axis=-1)
        if layer < N_A:
            h = modulate(rms_norm(x, norm_attn_g[layer]), sh_a, sc_a)
            q, k, v = jnp.split(h @ sb_w_qkv[layer], 3, axis=-1)
            o = stick_breaking_attention(split_heads(q), split_heads(k), split_heads(v))
            mix = merge_heads(o) @ sb_w_o[layer]
        else:
            if layer == N_A:
                kv_shift, kv_scale = jnp.split(c_act @ kv_ada_w + kv_ada_b, 2, axis=-1)
                hk = modulate(rms_norm(x, kv_norm_g), kv_shift, kv_scale)
                proj = hk @ w_kvf
                k_sh = rms_norm(split_heads(proj[..., :D]), k_norm_g)
                v_sh = split_heads(proj[..., D:2 * D])
                log_f = jax.nn.log_sigmoid(proj[..., 2 * D:].astype(jnp.float32) + b_f)
                fcum = lax.cumsum(log_f, axis=1).transpose(0, 2, 1)
            i = layer - N_A
            h = modulate(rms_norm(x, norm_attn_g[layer]), sh_a, sc_a)
            q = rms_norm(split_heads(h @ fox_w_q[i]), q_norm_g[i])
            o = forgetting_attention(q, k_sh, v_sh, fcum)
            mix = merge_heads(o) @ fox_w_o[i]
        x = x + g_a[:, None, :] * mix
        h = modulate(rms_norm(x, norm_ffn_g[layer]), sh_f, sc_f)
        x = x + g_f[:, None, :] * swiglu(h, w_ffn_in[layer], w_ffn_down[layer])
    return x
```

```cpp
#include <hip/hip_runtime.h>
#include <hip/hip_cooperative_groups.h>
#include <cstdio>
#include <cstdint>
namespace cg = cooperative_groups;
namespace pg8 {
#define PG8_LAS __attribute__((address_space(3)))
typedef unsigned short bf16_t;
typedef short bf16x8 __attribute__((ext_vector_type(8)));
typedef float f32x4 __attribute__((ext_vector_type(4)));
typedef unsigned u32x4 __attribute__((ext_vector_type(4)));
constexpr int BM = 256, BK = 64, HALF = 128, HTB = HALF * BK * 2  , STAGE_BYTES = 8 * HTB, NXCD = 8, WGM = 8;

__host__ __device__ __forceinline__ int lds_byte(int r, int c) { const int st = (r >> 4) * 2 + (c >> 5), rr = r & 15, cc = c & 31, ob = rr * 64 + cc * 2; return st * 1024 + (ob ^ (((ob >> 9) & 1) << 5)); }
__host__ __device__ __forceinline__ void stage_rc(int b, int& R, int& C) { const int st = b / 1024, sb = b % 1024, swz = sb ^ (((sb >> 9) & 1) << 5); R = (st >> 1) * 16 + swz / 64; C = (st & 1) * 32 + (swz % 64) / 2; }
__host__ __device__ __forceinline__ int perm32(int rho) { const int n = rho >> 4, i = rho & 15; return 8 * (i >> 2) + 4 * n + (i & 3); }

struct Unit { int pm, pn; };
struct Gemm { const bf16_t* A; const bf16_t* Bt; int M, N, K; };

struct StaticOrder {
    int nM, nN, nwg, G, c;
    __host__ __device__ void init(int M, int N, int G_, int c_) { nM = M / BM; nN = N / BM; nwg = nM * nN; G = G_; c = c_; }
    __host__ __device__ bool next(int i, Unit& u) const {
        const long L = (long)i * G + c; if (L >= nwg) return false;
        int wgid = (int)L; { const int q = nwg / NXCD, r = nwg % NXCD, xcd = wgid % NXCD, off = wgid / NXCD; wgid = (xcd < r ? xcd * (q + 1) : r * (q + 1) + (xcd - r) * q) + off; }
        const int nig = WGM * nN, gid = wgid / nig, fm = gid * WGM, gsz = (nM - fm) < WGM ? (nM - fm) : WGM;
        u.pm = fm + ((wgid % nig) % gsz); u.pn = (wgid % nig) / gsz; return true;
    }
    __device__ __forceinline__ void a_ready(const Unit&) const {}
    __device__ __forceinline__ void done(const Unit&) const {}
};

}
namespace pg8 {
__device__ __forceinline__ unsigned cvt_pk_bf16(float lo, float hi) { unsigned r; asm volatile("v_cvt_pk_bf16_f32 %0, %1, %2" : "=v"(r) : "v"(lo), "v"(hi)); return r; }
struct EpiQKV {
    static constexpr bool PERM = true, AFTER_DRAIN = false;
    bf16_t* O; size_t split_stride; float scale0;
    __device__ __forceinline__ void operator()(const f32x4 (&acc)[2][2][4][2], const Unit& u, int wr, int wc, int fr, int fq) const {
        const int row0 = u.pm * BM + wr * 64 + fr; const int t = u.pn >> 2; bf16_t* base = O + (size_t)t * split_stride; const float sc = (t == 0) ? scale0 : 1.f;
        const int col0 = (u.pn & 3) * BM + wc * 32 + 8 * fq;
#pragma unroll
        for (int ai = 0; ai < 2; ++ai)
#pragma unroll
            for (int m = 0; m < 4; ++m) { bf16_t* rowp = base + (size_t)(row0 + ai * HALF + m * 16) * 1024 + col0;
#pragma unroll
                for (int bj = 0; bj < 2; ++bj) { const f32x4 v0 = acc[ai][bj][m][0] * sc, v1 = acc[ai][bj][m][1] * sc;
                    u32x4 w; w.x = cvt_pk_bf16(v0[0], v0[1]); w.y = cvt_pk_bf16(v0[2], v0[3]); w.z = cvt_pk_bf16(v1[0], v1[1]); w.w = cvt_pk_bf16(v1[2], v1[3]);
                    *(u32x4*)(rowp + bj * HALF) = w; } }
    }
};
struct EpiRes {
    static constexpr bool PERM = false, AFTER_DRAIN = false;
    const float* base; float* out; const float* gate; int gate_bstride;
    __device__ __forceinline__ void operator()(const f32x4 (&acc)[2][2][4][2], const Unit& u, int wr, int wc, int fr, int fq) const {
        const int b = (u.pm * BM) >> 13; const float* gp = gate + (size_t)b * gate_bstride;
        const int col0 = u.pn * BM + wc * 32 + 4 * fq;
        f32x4 gv[2][2];
#pragma unroll
        for (int bj = 0; bj < 2; ++bj)
#pragma unroll
            for (int n = 0; n < 2; ++n) gv[bj][n] = *(const f32x4*)(gp + col0 + bj * HALF + n * 16);
        f32x4 bsA[2][2][2], bsB[2][2][2];
#define ER_LOAD(dst, k) do { _Pragma("unroll") for (int m2 = 0; m2 < 2; ++m2) { const size_t off_ = (size_t)(u.pm * BM + ((k) >> 1) * HALF + wr * 64 + (2 * ((k) & 1) + m2) * 16 + fr) * 1024 + col0; \
            _Pragma("unroll") for (int bj = 0; bj < 2; ++bj) _Pragma("unroll") for (int n = 0; n < 2; ++n) dst[m2][bj][n] = *(const f32x4*)(base + off_ + bj * HALF + n * 16); } } while (0)
#define ER_STORE(src, k) do { _Pragma("unroll") for (int m2 = 0; m2 < 2; ++m2) { const size_t off_ = (size_t)(u.pm * BM + ((k) >> 1) * HALF + wr * 64 + (2 * ((k) & 1) + m2) * 16 + fr) * 1024 + col0; \
            _Pragma("unroll") for (int bj = 0; bj < 2; ++bj) _Pragma("unroll") for (int n = 0; n < 2; ++n) *(f32x4*)(out + off_ + bj * HALF + n * 16) = src[m2][bj][n] + gv[bj][n] * acc[(k) >> 1][bj][2 * ((k) & 1) + m2][n]; } } while (0)
        ER_LOAD(bsA, 0); ER_LOAD(bsB, 1); asm volatile("" ::: "memory");
        ER_STORE(bsA, 0); ER_LOAD(bsA, 2); asm volatile("" ::: "memory");
        ER_STORE(bsB, 1); ER_LOAD(bsB, 3); asm volatile("" ::: "memory");
        ER_STORE(bsA, 2); ER_STORE(bsB, 3);
#undef ER_LOAD
#undef ER_STORE
    }
};
struct EpiResN {
    static constexpr bool PERM = false, AFTER_DRAIN = false;
    const float* base; float* out; const float* gate; int gate_bstride; bf16_t* A2; const float* ng; const float* nscale; float* part;
    __device__ __forceinline__ void operator()(const f32x4 (&acc)[2][2][4][2], const Unit& u, int wr, int wc, int fr, int fq) const {
        const int b = (u.pm * BM) >> 13; const float* gp = gate + (size_t)b * gate_bstride; const float* sp = nscale + (size_t)b * gate_bstride;
        const int col0 = u.pn * BM + wc * 32 + 4 * fq;
        f32x4 gv[2][2], av[2][2];
#pragma unroll
        for (int bj = 0; bj < 2; ++bj)
#pragma unroll
            for (int n = 0; n < 2; ++n) { const int c = col0 + bj * HALF + n * 16; gv[bj][n] = *(const f32x4*)(gp + c); av[bj][n] = *(const f32x4*)(ng + c) * (1.0f + *(const f32x4*)(sp + c)); }
#pragma unroll
        for (int ai = 0; ai < 2; ++ai) {
          for (int mh = 0; mh < 2; ++mh) {
            f32x4 bs[4][2][2];
#pragma unroll
            for (int m = 2 * mh; m < 2 * mh + 2; ++m) { const size_t off = (size_t)(u.pm * BM + ai * HALF + wr * 64 + m * 16 + fr) * 1024 + col0;
#pragma unroll
                for (int bj = 0; bj < 2; ++bj)
#pragma unroll
                    for (int n = 0; n < 2; ++n) bs[m][bj][n] = *(const f32x4*)(base + off + bj * HALF + n * 16); }
            asm volatile("" ::: "memory");
#pragma unroll
            for (int m = 2 * mh; m < 2 * mh + 2; ++m) { const int row = u.pm * BM + ai * HALF + wr * 64 + m * 16 + fr; const size_t off = (size_t)row * 1024 + col0; float ss = 0.f;
#pragma unroll
                for (int bj = 0; bj < 2; ++bj)
#pragma unroll
                    for (int n = 0; n < 2; ++n) { const f32x4 x1 = bs[m][bj][n] + gv[bj][n] * acc[ai][bj][m][n];
                        *(f32x4*)(out + off + bj * HALF + n * 16) = x1; ss += (x1[0] * x1[0] + x1[1] * x1[1]) + (x1[2] * x1[2] + x1[3] * x1[3]);
                        const f32x4 y = x1 * av[bj][n]; unsigned long long w = (unsigned long long)cvt_pk_bf16(y[0], y[1]) | ((unsigned long long)cvt_pk_bf16(y[2], y[3]) << 32);
                        *(unsigned long long*)(A2 + off + bj * HALF + n * 16) = w; }
                ss += __shfl_xor(ss, 16); ss += __shfl_xor(ss, 32);
                if (fq == 0) __hip_atomic_fetch_add(part + row, ss, __ATOMIC_RELAXED, __HIP_MEMORY_SCOPE_AGENT); }
          }
        }
    }
};
__device__ __forceinline__ void glds4(const void* gsrc, unsigned lds_dst) { unsigned keep;
  asm volatile("s_mov_b32 %0, m0\n\ts_mov_b32 m0, %2\n\ts_nop 0\n\tglobal_load_lds_dword %1, off\n\ts_mov_b32 m0, %0" : "=&s"(keep) : "v"(gsrc), "s"(lds_dst) : "memory"); }
struct SwiOrder {
    StaticOrder so; const float* part; const float* bias2; unsigned ldsx; mutable int k;
    __device__ bool next(int i, Unit& u) const { return so.next(i, u); }
    __device__ __forceinline__ void a_ready(const Unit& u) const {
        const int wid = __builtin_amdgcn_readfirstlane(threadIdx.x >> 6), lane = threadIdx.x & 63; const unsigned dst = ldsx + (unsigned)((k & 1) * 2048 + wid * 256); ++k;
        const float* src = (wid < 4) ? part + u.pm * BM + wid * 64 + lane : bias2 + (size_t)((u.pm * BM) >> 13) * 5632 + u.pn * BM + (wid - 4) * 64 + lane;
        glds4(src, (unsigned)__builtin_amdgcn_readfirstlane(dst));
    }
    __device__ __forceinline__ void done(const Unit&) const {}
};
struct EpiSwiGLU {
    static constexpr bool PERM = true, AFTER_DRAIN = false;
    bf16_t* O; unsigned ldsx; float eps; mutable int k;
    __device__ __forceinline__ void operator()(const f32x4 (&acc)[2][2][4][2], const Unit& u, int wr, int wc, int fr, int fq) const {
        const int row0 = u.pm * BM + wr * 64 + fr; const int col0 = u.pn * 128 + wc * 32 + 8 * fq;
        const PG8_LAS float* xs = (const PG8_LAS float*)(size_t)(ldsx + (unsigned)((k & 1) * 2048)); ++k;
        f32x4 bv[2][2]; float rs[2][4];
#pragma unroll
        for (int ai = 0; ai < 2; ++ai)
#pragma unroll
            for (int m = 0; m < 4; ++m) rs[ai][m] = xs[ai * HALF + wr * 64 + m * 16 + fr];
#pragma unroll
        for (int bj = 0; bj < 2; ++bj)
#pragma unroll
            for (int n = 0; n < 2; ++n) bv[bj][n] = *(const PG8_LAS f32x4*)(xs + 256 + bj * HALF + wc * 32 + 8 * fq + 4 * n);
#pragma unroll
        for (int ai = 0; ai < 2; ++ai)
#pragma unroll
            for (int m = 0; m < 4; ++m) { const int row = row0 + ai * HALF + m * 16;
                const float rstd = __builtin_amdgcn_rsqf(rs[ai][m] * (1.0f / 1024.0f) + eps);
                bf16_t* rowp = O + (size_t)row * 2816 + col0; float r[8];
#pragma unroll
                for (int n = 0; n < 2; ++n)
#pragma unroll
                    for (int e = 0; e < 4; ++e) { const float g = acc[ai][0][m][n][e] * rstd + bv[0][n][e], up = acc[ai][1][m][n][e] * rstd + bv[1][n][e];
                        const float sg = __builtin_amdgcn_rcpf(1.f + __builtin_amdgcn_exp2f(-1.4426950408889634f * g)); r[n * 4 + e] = g * sg * up; }
                u32x4 w; w.x = cvt_pk_bf16(r[0], r[1]); w.y = cvt_pk_bf16(r[2], r[3]); w.z = cvt_pk_bf16(r[4], r[5]); w.w = cvt_pk_bf16(r[6], r[7]);
                *(u32x4*)rowp = w; }
    }
};
struct EpiKVQ {
    static constexpr bool PERM = true, AFTER_DRAIN = false;
    bf16_t *Kb, *Vb, *Qb; const float *kg, *qg; float qscale, eps;
    __device__ __forceinline__ void operator()(const f32x4 (&acc)[2][2][4][2], const Unit& u, int wr, int wc, int fr, int fq) const {
        const int kind = u.pn >> 2; const int pm = (kind == 2) ? u.pm - 64 : u.pm; const int row0 = pm * BM + wr * 64 + fr;
        if (kind == 1) {
            const int col0 = (u.pn & 3) * BM + wc * 32 + 8 * fq;
#pragma unroll
            for (int ai = 0; ai < 2; ++ai)
#pragma unroll
                for (int m = 0; m < 4; ++m) { bf16_t* rowp = Vb + (size_t)(row0 + ai * HALF + m * 16) * 1024 + col0;
#pragma unroll
                    for (int bj = 0; bj < 2; ++bj) { const f32x4 v0 = acc[ai][bj][m][0], v1 = acc[ai][bj][m][1];
                        u32x4 w; w.x = cvt_pk_bf16(v0[0], v0[1]); w.y = cvt_pk_bf16(v0[2], v0[3]); w.z = cvt_pk_bf16(v1[0], v1[1]); w.w = cvt_pk_bf16(v1[2], v1[3]);
                        *(u32x4*)(rowp + bj * HALF) = w; } }
        } else {
            bf16_t* Ob = (kind == 0) ? Kb : Qb; const float* gsrc = (kind == 0) ? kg : qg; const float sc = (kind == 0) ? 1.f : qscale;
            f32x4 gv[2][2];
#pragma unroll
            for (int bj = 0; bj < 2; ++bj)
#pragma unroll
                for (int n = 0; n < 2; ++n) gv[bj][n] = *(const f32x4*)(gsrc + bj * 32 + 8 * fq + 4 * n) * sc;
            const int col0 = (u.pn & 3) * BM + wc * 64 + 8 * fq;
#pragma unroll
            for (int ai = 0; ai < 2; ++ai)
#pragma unroll
                for (int m = 0; m < 4; ++m) { float ss = 0.f;
#pragma unroll
                    for (int bj = 0; bj < 2; ++bj)
#pragma unroll
                        for (int n = 0; n < 2; ++n) { const f32x4 v = acc[ai][bj][m][n]; ss += (v[0] * v[0] + v[1] * v[1]) + (v[2] * v[2] + v[3] * v[3]); }
                    ss += __shfl_xor(ss, 16); ss += __shfl_xor(ss, 32);
                    const float rstd = 1.0f / sqrtf(ss * (1.0f / 64.0f) + eps);
                    bf16_t* rowp = Ob + (size_t)(row0 + ai * HALF + m * 16) * 1024 + col0;
#pragma unroll
                    for (int bj = 0; bj < 2; ++bj) { const f32x4 v0 = acc[ai][bj][m][0] * rstd * gv[bj][0], v1 = acc[ai][bj][m][1] * rstd * gv[bj][1];
                        u32x4 w; w.x = cvt_pk_bf16(v0[0], v0[1]); w.y = cvt_pk_bf16(v0[2], v0[3]); w.z = cvt_pk_bf16(v1[0], v1[1]); w.w = cvt_pk_bf16(v1[2], v1[3]);
                        *(u32x4*)(rowp + bj * 32) = w; } }
        }
    }
};
struct StackOrder {
    int G, c;
    __device__ bool next(int i, Unit& u) const {
        const int nwg = 768; const long L = (long)i * G + c; if (L >= nwg) return false;
        int wgid = (int)L; { const int q = nwg / NXCD, xcd = wgid % NXCD, off = wgid / NXCD; wgid = xcd * q + off; }
        if (wgid < 512) { const int nN = 8, nig = WGM * nN, gid = wgid / nig; u.pm = gid * WGM + ((wgid % nig) % WGM); u.pn = (wgid % nig) / WGM; }
        else { const int w2 = wgid - 512; const int nN = 4, nig = WGM * nN, gid = w2 / nig; u.pm = 64 + gid * WGM + ((w2 % nig) % WGM); u.pn = 8 + (w2 % nig) / WGM; }
        return true;
    }
    __device__ __forceinline__ void a_ready(const Unit&) const {}
    __device__ __forceinline__ void done(const Unit&) const {}
};
}
namespace pg8 {
template <class Epi, class Sched, bool ALIGN_EPI = false, bool SP2 = false>
__device__ __forceinline__ void gemm_phase(PG8_LAS unsigned char* lds, const Gemm g, const Sched& S, const Epi& E) {
    const int tid = threadIdx.x, wid = __builtin_amdgcn_readfirstlane(tid >> 6), lane = tid & 63, wr = wid >> 2, wc = wid & 3, fr = lane & 15, fq = lane >> 4;
    const int K = g.K, nt = K / BK;
    unsigned voffA[2], voffB[2];
#pragma unroll
    for (int i = 0; i < 2; ++i) { int R, C; stage_rc(tid * 16 + i * 8192, R, C); const int Rb = Epi::PERM ? ((R & ~31) + perm32(R & 31)) : R;
        voffA[i] = (unsigned)(R * K + C) * 2u; voffB[i] = (unsigned)(Rb * K + C) * 2u; }
    const size_t kstep = (size_t)(BK * 2);
    const size_t hstep = (size_t)HALF * K * 2;
    const size_t tstep = 2 * hstep;
    const unsigned ldsw = (unsigned)wid * 1024u;
    const int aoff = lds_byte(wr * 64 + fr, fq * 8), boff = lds_byte(wc * 32 + fr, fq * 8);
#define PG8_SA(b, h) (((b) * 2 + (h)) * HTB)
#define PG8_SB(b, h) ((4 + (b) * 2 + (h)) * HTB)
#define PG8_STAGE(bufoff, gbase, voff) do { _Pragma("unroll") for (int _i = 0; _i < 2; ++_i) \
        __builtin_amdgcn_global_load_lds((const unsigned*)((const char*)(gbase) + (voff)[_i]), (PG8_LAS unsigned*)(lds + (bufoff) + ldsw + _i * 8192), 16, 0, 0); } while (0)
#define PG8_LDA(dst, b, h) do { _Pragma("unroll") for (int m = 0; m < 4; ++m) _Pragma("unroll") for (int k = 0; k < 2; ++k) dst[m][k] = *(const PG8_LAS bf16x8*)(lds + PG8_SA(b, h) + aoff + m * 2048 + k * 1024); } while (0)
#define PG8_LDB(dst, b, h) do { _Pragma("unroll") for (int n = 0; n < 2; ++n) _Pragma("unroll") for (int k = 0; k < 2; ++k) dst[n][k] = *(const PG8_LAS bf16x8*)(lds + PG8_SB(b, h) + boff + n * 2048 + k * 1024); } while (0)
#define PG8_MMA(ai, bj, At, Bt) do { __builtin_amdgcn_s_setprio(1); _Pragma("unroll") for (int m = 0; m < 4; ++m) _Pragma("unroll") for (int n = 0; n < 2; ++n) _Pragma("unroll") for (int k = 0; k < 2; ++k) \
        acc[ai][bj][m][n] = __builtin_amdgcn_mfma_f32_16x16x32_bf16(Bt[n][k], At[m][k], acc[ai][bj][m][n], 0, 0, 0); __builtin_amdgcn_s_setprio(0); } while (0)
#define PG8_WAIT_V(n) asm volatile("s_waitcnt vmcnt(" #n ")" ::: "memory")
#define PG8_WAIT_L(n) asm volatile("s_waitcnt lgkmcnt(" #n ")" ::: "memory")
#define PG8_BAR __builtin_amdgcn_s_barrier()
#define PG8_SCHED __builtin_amdgcn_sched_barrier(0)
    Unit cur, nxt; int ui = 0;
    if (!S.next(0, cur)) return;
    f32x4 acc[2][2][4][2];
#pragma unroll
    for (int a = 0; a < 2; ++a)
#pragma unroll
        for (int b = 0; b < 2; ++b)
#pragma unroll
            for (int m = 0; m < 4; ++m)
#pragma unroll
                for (int n = 0; n < 2; ++n) acc[a][b][m][n] = (f32x4){0.f, 0.f, 0.f, 0.f};
    bf16x8 At[4][2], B0[2][2], B1[2][2];
    const char* cA = (const char*)g.A + (size_t)cur.pm * tstep; const char* cB = (const char*)g.Bt + (size_t)cur.pn * tstep;
    S.a_ready(cur);
    if constexpr (SP2) {
        PG8_STAGE(PG8_SB(0, 0), cB, voffB); PG8_STAGE(PG8_SB(0, 1), cB + hstep, voffB); PG8_STAGE(PG8_SA(0, 0), cA, voffA); PG8_STAGE(PG8_SA(0, 1), cA + hstep, voffA);
        if (wr == 1) PG8_BAR;
        PG8_WAIT_V(2); PG8_BAR;
        PG8_STAGE(PG8_SB(1, 0), cB + kstep, voffB); PG8_STAGE(PG8_SA(1, 0), cA + kstep, voffA); PG8_STAGE(PG8_SB(1, 1), cB + hstep + kstep, voffB);
        PG8_WAIT_V(6); PG8_BAR;
    } else {
        PG8_STAGE(PG8_SB(0, 0), cB, voffB); PG8_STAGE(PG8_SA(0, 0), cA, voffA); PG8_STAGE(PG8_SB(0, 1), cB + hstep, voffB); PG8_STAGE(PG8_SA(0, 1), cA + hstep, voffA);
        if (wr == 1) PG8_BAR;
        PG8_WAIT_V(4); PG8_BAR;
        PG8_STAGE(PG8_SB(1, 0), cB + kstep, voffB); PG8_STAGE(PG8_SA(1, 0), cA + kstep, voffA); PG8_STAGE(PG8_SB(1, 1), cB + hstep + kstep, voffB);
        PG8_WAIT_V(6); PG8_BAR;
    }
    for (;;) {
        const bool has_next = S.next(ui + 1, nxt);
        const char* nA = has_next ? (const char*)g.A + (size_t)nxt.pm * tstep : cA; const char* nB = has_next ? (const char*)g.Bt + (size_t)nxt.pn * tstep : cB;
        for (int t = 0; t < nt; t += 2) {
            const bool last = (t == nt - 2);
            const char* a1 = cA + (size_t)(t + 1) * kstep;
            const char* a2 = last ? nA : cA + (size_t)(t + 2) * kstep; const char* b2 = last ? nB : cB + (size_t)(t + 2) * kstep;
            const char* a3 = a2 + kstep; const char* b3 = b2 + kstep;
            if (last && has_next) S.a_ready(nxt);
            if constexpr (SP2) {
            PG8_LDB(B0, 0, 0); PG8_LDB(B1, 0, 1); PG8_SCHED; PG8_LDA(At, 0, 0); PG8_STAGE(PG8_SA(1, 1), a1 + hstep, voffA);
            PG8_WAIT_V(8); PG8_WAIT_L(0); PG8_BAR; PG8_MMA(0, 0, At, B0); PG8_MMA(0, 1, At, B1); PG8_BAR; PG8_SCHED;
            PG8_LDA(At, 0, 1); PG8_STAGE(PG8_SB(0, 0), b2, voffB); PG8_STAGE(PG8_SB(0, 1), b2 + hstep, voffB); PG8_STAGE(PG8_SA(0, 0), a2, voffA);
            PG8_WAIT_V(8); PG8_WAIT_L(0); PG8_BAR; PG8_MMA(1, 0, At, B0); PG8_MMA(1, 1, At, B1); PG8_BAR; PG8_SCHED;
            PG8_LDB(B0, 1, 0); PG8_LDB(B1, 1, 1); PG8_SCHED; PG8_LDA(At, 1, 0); PG8_STAGE(PG8_SA(0, 1), a2 + hstep, voffA);
            PG8_WAIT_V(8); PG8_WAIT_L(0); PG8_BAR; PG8_MMA(0, 0, At, B0); PG8_MMA(0, 1, At, B1); PG8_BAR; PG8_SCHED;
            PG8_LDA(At, 1, 1); PG8_STAGE(PG8_SB(1, 0), b3, voffB); PG8_STAGE(PG8_SB(1, 1), b3 + hstep, voffB); PG8_STAGE(PG8_SA(1, 0), a3, voffA);
            PG8_WAIT_V(8); PG8_WAIT_L(0); PG8_BAR; PG8_MMA(1, 0, At, B0); PG8_MMA(1, 1, At, B1); PG8_BAR; PG8_SCHED;
            } else {
            PG8_LDB(B0, 0, 0); PG8_SCHED; PG8_LDA(At, 0, 0); PG8_STAGE(PG8_SA(1, 1), a1 + hstep, voffA);
            PG8_WAIT_L(8); PG8_BAR; PG8_WAIT_L(0); PG8_MMA(0, 0, At, B0); PG8_BAR; PG8_SCHED;
            PG8_LDB(B1, 0, 1); PG8_STAGE(PG8_SB(0, 0), b2, voffB);
            PG8_BAR; PG8_WAIT_L(0); PG8_MMA(0, 1, At, B1); PG8_BAR;
            PG8_LDA(At, 0, 1); PG8_STAGE(PG8_SA(0, 0), a2, voffA);
            PG8_BAR; PG8_WAIT_L(0); PG8_MMA(1, 0, At, B0); PG8_BAR; PG8_SCHED;
            PG8_STAGE(PG8_SB(0, 1), b2 + hstep, voffB);
            PG8_WAIT_V(6); PG8_BAR; PG8_MMA(1, 1, At, B1); PG8_BAR;
            PG8_LDB(B0, 1, 0); PG8_SCHED; PG8_LDA(At, 1, 0); PG8_STAGE(PG8_SA(0, 1), a2 + hstep, voffA);
            PG8_WAIT_L(8); PG8_BAR; PG8_WAIT_L(0); PG8_MMA(0, 0, At, B0); PG8_BAR; PG8_SCHED;
            PG8_LDB(B1, 1, 1); PG8_STAGE(PG8_SB(1, 0), b3, voffB);
            PG8_BAR; PG8_WAIT_L(0); PG8_MMA(0, 1, At, B1); PG8_BAR;
            PG8_LDA(At, 1, 1); PG8_STAGE(PG8_SA(1, 0), a3, voffA);
            PG8_BAR; PG8_WAIT_L(0); PG8_MMA(1, 0, At, B0); PG8_BAR; PG8_SCHED;
            PG8_STAGE(PG8_SB(1, 1), b3 + hstep, voffB);
            PG8_WAIT_V(6); PG8_BAR; PG8_MMA(1, 1, At, B1); PG8_BAR;
            }
        }
        if constexpr (ALIGN_EPI) { if (wr == 0) PG8_BAR; }
        if constexpr (!Epi::AFTER_DRAIN) { E(acc, cur, wr, wc, fr, fq); S.done(cur); }
        if (!has_next) break;
#pragma unroll
        for (int a = 0; a < 2; ++a)
#pragma unroll
            for (int b = 0; b < 2; ++b)
#pragma unroll
                for (int m = 0; m < 4; ++m)
#pragma unroll
                    for (int n = 0; n < 2; ++n) acc[a][b][m][n] = (f32x4){0.f, 0.f, 0.f, 0.f};
        cur = nxt; cA = nA; cB = nB; ++ui;
        if constexpr (ALIGN_EPI) { if (wr == 1) PG8_BAR; }
    }
    PG8_WAIT_V(0);
    if constexpr (!ALIGN_EPI) { if (wr == 0) PG8_BAR; }
    PG8_BAR;
    if constexpr (Epi::AFTER_DRAIN) { E.fused(acc, cur, wr, wc, fr, fq, lds, wid, lane); S.done(cur); }
#undef PG8_SA
#undef PG8_SB
#undef PG8_STAGE
#undef PG8_LDA
#undef PG8_LDB
#undef PG8_MMA
#undef PG8_WAIT_V
#undef PG8_WAIT_L
#undef PG8_BAR
#undef PG8_SCHED
}
}
namespace att {
#define ALAS __attribute__((address_space(3)))
typedef unsigned short bf16_t;
using bf16x8 = __attribute__((ext_vector_type(8))) short;
using s16x4 = __attribute__((ext_vector_type(4))) short;
using f32x16 = __attribute__((ext_vector_type(16))) float;
using f32x4 = __attribute__((ext_vector_type(4))) float;
using u32x4 = __attribute__((ext_vector_type(4))) unsigned;
constexpr int SEQ = 8192, DM = 1024, NHEAD = 16, NW = 8, QBLK = 32, QB = 256, KVBLK = 64, NSLOT = 3, SLOTB = 8192;
constexpr int LDS_KV = 0, LDS_WS = 3 * 32768, LDS_OST = LDS_WS + NW * 64 * 4, LDS_FC = LDS_OST,
    LDS_FLG = LDS_FC + SEQ * 4, LDS_END = LDS_FLG + 128;
static_assert(LDS_END <= 147456 - 64, "attention LDS");
__device__ __forceinline__ int crow(int r, int hi) { return (r & 3) + 8 * (r >> 2) + 4 * hi; }
__device__ __forceinline__ void glds16(const void* gsrc, unsigned lds_dst) { unsigned keep;
  asm volatile("s_mov_b32 %0, m0\n\ts_mov_b32 m0, %2\n\ts_nop 0\n\tglobal_load_lds_dwordx4 %1, off\n\ts_mov_b32 m0, %0" : "=&s"(keep) : "v"(gsrc), "s"(lds_dst) : "memory"); }
typedef float f32x2_t __attribute__((ext_vector_type(2))); typedef __bf16 bf16x2_t __attribute__((ext_vector_type(2)));
__device__ __forceinline__ unsigned cvtpk_s(float lo, float hi) { f32x2_t v = {lo, hi}; bf16x2_t b = __builtin_convertvector(v, bf16x2_t); return __builtin_bit_cast(unsigned, b); }
#define AWAIT_BAR(N) asm volatile("s_waitcnt vmcnt(" #N ") lgkmcnt(0)\n\ts_barrier" ::: "memory")
typedef ALAS const char* lds_cptr;
__device__ __forceinline__ float xhalf(float v, int hi) { auto rr = __builtin_amdgcn_permlane32_swap(__float_as_uint(v), __float_as_uint(v), false, false); return __uint_as_float(hi ? rr[0] : rr[1]); }

__device__ __forceinline__ void qkt(f32x16& p0, f32x16& p1, unsigned kq, int so, const bf16x8* qr, const f32x16& cinit) {
#pragma unroll
  for (int d0 = 0; d0 < 4; ++d0) {
    const lds_cptr ka = (lds_cptr)(uintptr_t)((kq ^ (unsigned)(d0 << 5)) + (unsigned)so);
    const bf16x8 b0 = *(const ALAS bf16x8*)(ka);
    const bf16x8 b1 = *(const ALAS bf16x8*)(ka + 4096);
    if (d0 == 0) { p0 = __builtin_amdgcn_mfma_f32_32x32x16_bf16(b0, qr[0], cinit, 0, 0, 0); p1 = __builtin_amdgcn_mfma_f32_32x32x16_bf16(b1, qr[0], cinit, 0, 0, 0); }
    else { p0 = __builtin_amdgcn_mfma_f32_32x32x16_bf16(b0, qr[d0], p0, 0, 0, 0); p1 = __builtin_amdgcn_mfma_f32_32x32x16_bf16(b1, qr[d0], p1, 0, 0, 0); } }
}
constexpr float SKIP_L2 = 151.0f;
typedef short v4i16_t __attribute__((ext_vector_type(4)));
__device__ __forceinline__ s16x4 vtr(lds_cptr p) { return __builtin_bit_cast(s16x4, __builtin_amdgcn_ds_read_tr16_b64_v4i16((ALAS v4i16_t*)p)); }
__device__ __forceinline__ void pv2(f32x16* o, lds_cptr vp, const f32x16& p0, const f32x16& p1) {
  bf16x8 pa[4];
  { u32x4 w;
    w = (u32x4){cvtpk_s(p0[0], p0[1]), cvtpk_s(p0[2], p0[3]), cvtpk_s(p0[4], p0[5]), cvtpk_s(p0[6], p0[7])}; pa[0] = __builtin_bit_cast(bf16x8, w);
    w = (u32x4){cvtpk_s(p0[8], p0[9]), cvtpk_s(p0[10], p0[11]), cvtpk_s(p0[12], p0[13]), cvtpk_s(p0[14], p0[15])}; pa[1] = __builtin_bit_cast(bf16x8, w);
    w = (u32x4){cvtpk_s(p1[0], p1[1]), cvtpk_s(p1[2], p1[3]), cvtpk_s(p1[4], p1[5]), cvtpk_s(p1[6], p1[7])}; pa[2] = __builtin_bit_cast(bf16x8, w);
    w = (u32x4){cvtpk_s(p1[8], p1[9]), cvtpk_s(p1[10], p1[11]), cvtpk_s(p1[12], p1[13]), cvtpk_s(p1[14], p1[15])}; pa[3] = __builtin_bit_cast(bf16x8, w); }
#pragma unroll
  for (int ks = 0; ks < 4; ++ks)
#pragma unroll
    for (int d0 = 0; d0 < 2; ++d0) { const s16x4 lo = vtr(vp + d0 * 4096 + ks * 1024), hh = vtr(vp + d0 * 4096 + ks * 1024 + 512);
      const bf16x8 vf = (bf16x8){lo[0], lo[1], lo[2], lo[3], hh[0], hh[1], hh[2], hh[3]};
      o[d0] = __builtin_amdgcn_mfma_f32_32x32x16_bf16(pa[ks], vf, o[d0], 0, 0, 0); }
}
template <bool BAND> __device__ __forceinline__ void sb_tile(f32x16& p0, f32x16& p1, float& R, int krel0, int hi) {
  f32x16 s0, s1;
#pragma unroll
  for (int r = 0; r < 16; ++r) {
    const float z0 = p0[r], z1 = p1[r];
    const float u0 = __builtin_amdgcn_logf(1.0f + __builtin_amdgcn_exp2f(-__builtin_fabsf(z0))), u1 = __builtin_amdgcn_logf(1.0f + __builtin_amdgcn_exp2f(-__builtin_fabsf(z1)));
    s0[r] = __builtin_fmaf(0.5f, z0 + __builtin_fabsf(z0), u0); s1[r] = __builtin_fmaf(0.5f, z1 + __builtin_fabsf(z1), u1); }
  if (BAND) {
#pragma unroll
    for (int r = 0; r < 16; ++r) { const int kr = krel0 + (r & 3) + 8 * (r >> 2); if (kr >= 0) s0[r] = 0.f; if (kr + 32 >= 0) s1[r] = 0.f; } }
#pragma unroll
  for (int g = 0; g < 4; ++g) { s0[4 * g + 2] += s0[4 * g + 3]; s0[4 * g + 1] += s0[4 * g + 2]; s0[4 * g] += s0[4 * g + 1];
                                s1[4 * g + 2] += s1[4 * g + 3]; s1[4 * g + 1] += s1[4 * g + 2]; s1[4 * g] += s1[4 * g + 1]; }
  float W[9]; W[8] = 0.f;
#pragma unroll
  for (int g = 7; g >= 0; --g) W[g] = W[g + 1] + (g < 4 ? s0[4 * g] : s1[4 * (g - 4)]);
  float base[8]; float tot0 = 0.f; const float Rold = R;
#pragma unroll
  for (int g = 0; g < 8; ++g) { auto rr = __builtin_amdgcn_permlane32_swap(__float_as_uint(W[g]), __float_as_uint(W[g + 1]), false, false);
    const float wp = __uint_as_float(hi ? rr[0] : rr[1]); base[g] = Rold + W[g + 1] + wp; if (g == 0) tot0 = W[0] + wp; }
  { const float pt = xhalf(tot0, hi); R = Rold + (hi ? pt : tot0); }
#pragma unroll
  for (int r = 0; r < 16; ++r) { p0[r] = __builtin_amdgcn_exp2f(p0[r] - (base[r >> 2] + s0[r])); p1[r] = __builtin_amdgcn_exp2f(p1[r] - (base[4 + (r >> 2)] + s1[r])); }
  if (BAND) {
#pragma unroll
    for (int r = 0; r < 16; ++r) { const int kr = krel0 + (r & 3) + 8 * (r >> 2); if (kr >= 0) p0[r] = 0.f; if (kr + 32 >= 0) p1[r] = 0.f; } }
}
template <bool BAND, bool WANT_MAX> __device__ __forceinline__ float fox_logits(f32x16& p0, f32x16& p1, const ALAS float* fc, int krel0) {
#pragma unroll
  for (int g = 0; g < 4; ++g) { const f32x4 f0 = *(const ALAS f32x4*)(fc + 8 * g), f1 = *(const ALAS f32x4*)(fc + 32 + 8 * g);
#pragma unroll
    for (int e = 0; e < 4; ++e) { p0[4 * g + e] -= f0[e]; p1[4 * g + e] -= f1[e]; } }
  if (BAND) {
#pragma unroll
    for (int r = 0; r < 16; ++r) { const int kr = krel0 + (r & 3) + 8 * (r >> 2); if (kr > 0) p0[r] = -INFINITY; if (kr + 32 > 0) p1[r] = -INFINITY; } }
  float a = 0.f;
  if (WANT_MAX) { a = __builtin_fmaxf(p0[0], p1[0]);
#pragma unroll
    for (int r = 1; r < 16; ++r) a = __builtin_fmaxf(a, __builtin_fmaxf(p0[r], p1[r])); }
  return a;
}
__device__ __forceinline__ void kread8(bf16x8* kf, unsigned kq, int so) {
#pragma unroll
  for (int d0 = 0; d0 < 4; ++d0) { const lds_cptr ka = (lds_cptr)(uintptr_t)((kq ^ (unsigned)(d0 << 5)) + (unsigned)so); kf[2 * d0] = *(const ALAS bf16x8*)(ka); kf[2 * d0 + 1] = *(const ALAS bf16x8*)(ka + 4096); }
}
__device__ __forceinline__ void kread4(bf16x8* kf, unsigned kq, int so, int half) {
#pragma unroll
  for (int d = 0; d < 2; ++d) { const int d0 = 2 * half + d; const lds_cptr ka = (lds_cptr)(uintptr_t)((kq ^ (unsigned)(d0 << 5)) + (unsigned)so); kf[2 * d0] = *(const ALAS bf16x8*)(ka); kf[2 * d0 + 1] = *(const ALAS bf16x8*)(ka + 4096); }
}
__device__ __forceinline__ void qk8(f32x16& p0, f32x16& p1, const bf16x8* kf, const bf16x8* qr, const f32x16& cinit) {
  p0 = __builtin_amdgcn_mfma_f32_32x32x16_bf16(kf[0], qr[0], cinit, 0, 0, 0); p1 = __builtin_amdgcn_mfma_f32_32x32x16_bf16(kf[1], qr[0], cinit, 0, 0, 0);
#pragma unroll
  for (int d0 = 1; d0 < 4; ++d0) { p0 = __builtin_amdgcn_mfma_f32_32x32x16_bf16(kf[2 * d0], qr[d0], p0, 0, 0, 0); p1 = __builtin_amdgcn_mfma_f32_32x32x16_bf16(kf[2 * d0 + 1], qr[d0], p1, 0, 0, 0); }
}
__device__ __forceinline__ void vread16(bf16x8* vf, lds_cptr vp) {
#pragma unroll
  for (int ks = 0; ks < 4; ++ks)
#pragma unroll
    for (int d0 = 0; d0 < 2; ++d0) { const s16x4 lo = vtr(vp + d0 * 4096 + ks * 1024), hh = vtr(vp + d0 * 4096 + ks * 1024 + 512);
      vf[2 * ks + d0] = (bf16x8){lo[0], lo[1], lo[2], lo[3], hh[0], hh[1], hh[2], hh[3]}; }
}
__device__ __forceinline__ void vread8(bf16x8* vf, lds_cptr vp, int half) {
#pragma unroll
  for (int k2 = 0; k2 < 2; ++k2)
#pragma unroll
    for (int d0 = 0; d0 < 2; ++d0) { const int ks = 2 * half + k2; const s16x4 lo = vtr(vp + d0 * 4096 + ks * 1024), hh = vtr(vp + d0 * 4096 + ks * 1024 + 512);
      vf[2 * ks + d0] = (bf16x8){lo[0], lo[1], lo[2], lo[3], hh[0], hh[1], hh[2], hh[3]}; }
}
__device__ __forceinline__ void pack4(bf16x8* pa, const f32x16& p0, const f32x16& p1) {
  u32x4 w;
  w = (u32x4){cvtpk_s(p0[0], p0[1]), cvtpk_s(p0[2], p0[3]), cvtpk_s(p0[4], p0[5]), cvtpk_s(p0[6], p0[7])}; pa[0] = __builtin_bit_cast(bf16x8, w);
  w = (u32x4){cvtpk_s(p0[8], p0[9]), cvtpk_s(p0[10], p0[11]), cvtpk_s(p0[12], p0[13]), cvtpk_s(p0[14], p0[15])}; pa[1] = __builtin_bit_cast(bf16x8, w);
  w = (u32x4){cvtpk_s(p1[0], p1[1]), cvtpk_s(p1[2], p1[3]), cvtpk_s(p1[4], p1[5]), cvtpk_s(p1[6], p1[7])}; pa[2] = __builtin_bit_cast(bf16x8, w);
  w = (u32x4){cvtpk_s(p1[8], p1[9]), cvtpk_s(p1[10], p1[11]), cvtpk_s(p1[12], p1[13]), cvtpk_s(p1[14], p1[15])}; pa[3] = __builtin_bit_cast(bf16x8, w);
}
__device__ __forceinline__ void pv8(f32x16* o, const bf16x8* pa, const bf16x8* vf) {
#pragma unroll
  for (int ks = 0; ks < 4; ++ks)
#pragma unroll
    for (int d0 = 0; d0 < 2; ++d0) o[d0] = __builtin_amdgcn_mfma_f32_32x32x16_bf16(pa[ks], vf[2 * ks + d0], o[d0], 0, 0, 0);
}
__device__ __forceinline__ void fox_init(f32x16& p0, f32x16& p1, const ALAS float* fc, float c) {
#pragma unroll
  for (int g = 0; g < 4; ++g) { const f32x4 f0 = *(const ALAS f32x4*)(fc + 8 * g), f1 = *(const ALAS f32x4*)(fc + 32 + 8 * g);
#pragma unroll
    for (int e = 0; e < 4; ++e) { p0[4 * g + e] = c - f0[e]; p1[4 * g + e] = c - f1[e]; } }
}
__device__ __forceinline__ void qk8acc(f32x16& p0, f32x16& p1, const bf16x8* kf, const bf16x8* qr) {
#pragma unroll
  for (int d0 = 0; d0 < 4; ++d0) { p0 = __builtin_amdgcn_mfma_f32_32x32x16_bf16(kf[2 * d0], qr[d0], p0, 0, 0, 0); p1 = __builtin_amdgcn_mfma_f32_32x32x16_bf16(kf[2 * d0 + 1], qr[d0], p1, 0, 0, 0); }
}
#define SBAR0() __builtin_amdgcn_sched_barrier(0)
#define SGB_PATTERN(NM, ND, NV) do { _Pragma("unroll") for (int g_ = 0; g_ < (NM); ++g_) { __builtin_amdgcn_sched_group_barrier(0x008, 1, 0); if ((ND) > 0) __builtin_amdgcn_sched_group_barrier(0x100, (ND), 0); if ((NV) > 0) __builtin_amdgcn_sched_group_barrier(0x002, (NV), 0); } } while (0)
template <int MODE> __device__ __forceinline__ void attn_unit(int b, int h, int qb, const bf16_t* Q, const bf16_t* __restrict__ K, const bf16_t* __restrict__ V, bf16_t* O, const float* FC2, const float* kgain, ALAS char* shm) {
  int tid = threadIdx.x; asm volatile("" : "+v"(tid));
  const int lane = tid & 63, r32 = lane & 31, hi = lane >> 5; const int wid = __builtin_amdgcn_readfirstlane(tid >> 6);
  const long rowbase = (long)b * SEQ; const int q0 = qb * QB;
  const bf16_t* Qw = Q + (rowbase + q0 + wid * QBLK) * DM + h * 64;
  const bf16_t *Kh = K + rowbase * DM + h * 64, *Vh = V + rowbase * DM + h * 64;
  const unsigned lds0 = (unsigned)(uintptr_t)shm;
  ALAS float* wsf = (ALAS float*)(shm + LDS_WS) + wid * 64;
  const bf16_t* ksrc = Kh + (long)(8 * wid + (lane >> 3)) * DM + (((lane & 7) ^ ((lane >> 3) & 7)) * 8);
  const bf16_t* vsrc = Vh + (long)(16 * (wid & 3) + (lane >> 2)) * DM + (wid >> 2) * 32 + (lane & 3) * 8;
  const unsigned pdst = lds0 + LDS_KV + wid * 1024;
#define DMA_PAIR(tA, sb) do { glds16(ksrc + (long)(tA) * KVBLK * DM, (unsigned)__builtin_amdgcn_readfirstlane(pdst + (sb))); glds16(ksrc + (long)((tA) - 1) * KVBLK * DM, (unsigned)__builtin_amdgcn_readfirstlane(pdst + (sb) + 8192)); \
    glds16(vsrc + (long)(tA) * KVBLK * DM, (unsigned)__builtin_amdgcn_readfirstlane(pdst + (sb) + 16384)); glds16(vsrc + (long)((tA) - 1) * KVBLK * DM, (unsigned)__builtin_amdgcn_readfirstlane(pdst + (sb) + 24576)); } while (0)
  const unsigned kq = (unsigned)(uintptr_t)((lds_cptr)shm + LDS_KV) + r32 * 128 + ((hi ^ (r32 & 7)) << 4);
  const lds_cptr vp0 = (lds_cptr)shm + LDS_KV + 16384 + ((lane >> 4) & 1) * 32 + (lane & 3) * 8 + (4 * hi + ((lane & 15) >> 2)) * 64;
  const int NT = (q0 + QB) / KVBLK, NS = NT / 2;
  DMA_PAIR(NT - 1, 0); DMA_PAIR(NT - 3, 32768);
  bf16x8 qr[4];
#pragma unroll
  for (int d0 = 0; d0 < 4; ++d0) qr[d0] = *reinterpret_cast<const bf16x8*>(&Qw[(long)r32 * DM + d0 * 16 + hi * 8]);
  const int qrel = wid * QBLK + r32;
  float fq2 = 0.f;
  if (MODE == 1) {
    const float* fsrc = FC2 + ((long)b * NHEAD + h) * SEQ; ALAS float* fc = (ALAS float*)(shm + LDS_FC);
    f32x4 fv[4];
#pragma unroll
    for (int j = 0; j < 4; ++j) { const int i = tid * 4 + j * 2048; if (i < q0 + QB) fv[j] = *(const f32x4*)(fsrc + i); }
#pragma unroll
    for (int j = 0; j < 4; ++j) { const int i = tid * 4 + j * 2048; if (i < q0 + QB) *(ALAS f32x4*)(fc + i) = fv[j]; }
    fq2 = fsrc[q0 + qrel];
  }
  f32x16 o[2]; o[0] = f32x16{}; o[1] = f32x16{};
  float R = 0.f;
  float mhat = 0.f;
  float zb = 0.f;
  if (MODE == 1) {
    float ss = 0.f;
#pragma unroll
    for (int d0 = 0; d0 < 4; ++d0)
#pragma unroll
      for (int e = 0; e < 8; ++e) { const float qv = __uint_as_float(((unsigned)(unsigned short)qr[d0][e]) << 16); ss += qv * qv; }
    ss += xhalf(ss, hi);
    float gm = __builtin_fabsf(kgain[lane]);
#pragma unroll
    for (int o_ = 1; o_ < 64; o_ <<= 1) gm = __builtin_fmaxf(gm, __shfl_xor(gm, o_));
    zb = sqrtf(ss) * gm * 8.0f * 1.01f;
  }
  ALAS unsigned* flg = (ALAS unsigned*)(shm + LDS_FLG);
  const int i_first = (wid < 4) ? 1 : 0;
  const f32x16 zc = f32x16{};
#define STEP_BODY(BANDV) do { \
      const int tA = NT - 1 - 2 * si; const int krA = tA * KVBLK - q0 + 4 * hi - qrel, krB = krA - KVBLK; \
      const lds_cptr vpA = vp0 + sbl, vpB = vp0 + sbl + 8192; \
      f32x16 pA0, pA1, pB0, pB1; \
      const bool skipA = (MODE == 0) && BANDV && (tA * KVBLK - q0 >= 32 * wid + 31);     \
      if (MODE == 0) { \
        if (!skipA) qkt(pA0, pA1, kq, sbl, qr, zc); \
        qkt(pB0, pB1, kq, sbl + 8192, qr, zc); \
        if (!skipA) sb_tile<BANDV>(pA0, pA1, R, krA, hi); \
        sb_tile<BANDV>(pB0, pB1, R, krB, hi); \
      } else { \
        f32x16 ci; { const float c = fq2 - mhat; _Pragma("unroll") for (int r = 0; r < 16; ++r) ci[r] = c; } \
        qkt(pA0, pA1, kq, sbl, qr, ci); qkt(pB0, pB1, kq, sbl + 8192, qr, ci); \
        const ALAS float* fc = (const ALAS float*)(shm + LDS_FC) + tA * KVBLK + 4 * hi; \
        if (BANDV && si == i_first) {         \
          float rm = __builtin_fmaxf(fox_logits<true, true>(pA0, pA1, fc, krA), fox_logits<true, true>(pB0, pB1, fc - KVBLK, krB)); \
          rm = __builtin_fmaxf(rm, xhalf(rm, hi)); mhat = rm; \
          _Pragma("unroll") for (int r = 0; r < 16; ++r) { pA0[r] -= rm; pA1[r] -= rm; pB0[r] -= rm; pB1[r] -= rm; } \
        } else { (void)fox_logits<BANDV, false>(pA0, pA1, fc, krA); (void)fox_logits<BANDV, false>(pB0, pB1, fc - KVBLK, krB); } \
        float sacc = 0.f; \
        _Pragma("unroll") for (int r = 0; r < 16; ++r) { pA0[r] = __builtin_amdgcn_exp2f(pA0[r]); pA1[r] = __builtin_amdgcn_exp2f(pA1[r]); pB0[r] = __builtin_amdgcn_exp2f(pB0[r]); pB1[r] = __builtin_amdgcn_exp2f(pB1[r]); \
          sacc += (pA0[r] + pA1[r]) + (pB0[r] + pB1[r]); } \
        R += sacc; \
      } \
      if (!skipA) pv2(o, vpA, pA0, pA1); \
      pv2(o, vpB, pB0, pB1); \
    } while (0)
#define STEP_PIPE() do { \
      const int tA = NT - 1 - 2 * si; \
      const lds_cptr vpA = vp0 + sbl, vpB = vp0 + sbl + 8192; \
      f32x16 pA0, pA1, pB0, pB1; bf16x8 kfa[8], kfb[8], vfa[8], vfb[8], paA[4], paB[4]; \
      if (MODE == 0) { \
        SBAR0(); kread8(kfa, kq, sbl); SBAR0(); \
        qk8(pA0, pA1, kfa, qr, zc); kread8(kfb, kq, sbl + 8192); SGB_PATTERN(8, 1, 0); SBAR0(); \
        qk8(pB0, pB1, kfb, qr, zc); sb_tile<false>(pA0, pA1, R, 0, hi); pack4(paA, pA0, pA1); SGB_PATTERN(8, 0, 58); SBAR0(); \
        vread16(vfa, vpA); __builtin_amdgcn_sched_group_barrier(0x100, 16, 0); \
        pv8(o, paA, vfa); sb_tile<false>(pB0, pB1, R, 0, hi); pack4(paB, pB0, pB1); SGB_PATTERN(8, 0, 58); SBAR0(); \
        vread16(vfb, vpB); pv8(o, paB, vfb); SBAR0(); \
      } else { \
        const ALAS float* fc = (const ALAS float*)(shm + LDS_FC) + tA * KVBLK + 4 * hi; const float c = fq2 - mhat; \
        SBAR0(); kread8(kfa, kq, sbl); fox_init(pA0, pA1, fc, c); SBAR0(); \
        qk8acc(pA0, pA1, kfa, qr); kread4(kfb, kq, sbl + 8192, 0); fox_init(pB0, pB1, fc - KVBLK, c); SGB_PATTERN(8, 2, 8); SBAR0(); \
        kread4(kfb, kq, sbl + 8192, 1); qk8acc(pB0, pB1, kfb, qr); { float sa = 0.f; \
          _Pragma("unroll") for (int r = 0; r < 16; ++r) { pA0[r] = __builtin_amdgcn_exp2f(pA0[r]); pA1[r] = __builtin_amdgcn_exp2f(pA1[r]); sa += pA0[r] + pA1[r]; } R += sa; } \
        pack4(paA, pA0, pA1); SGB_PATTERN(8, 0, 11); SBAR0(); \
        vread16(vfa, vpA); __builtin_amdgcn_sched_group_barrier(0x100, 16, 0); pv8(o, paA, vfa); { float sa = 0.f; \
          _Pragma("unroll") for (int r = 0; r < 16; ++r) { pB0[r] = __builtin_amdgcn_exp2f(pB0[r]); pB1[r] = __builtin_amdgcn_exp2f(pB1[r]); sa += pB0[r] + pB1[r]; } R += sa; } \
        pack4(paB, pB0, pB1); SGB_PATTERN(8, 0, 11); SBAR0(); \
        vread16(vfb, vpB); pv8(o, paB, vfb); SBAR0(); \
      } \
    } while (0)
  int sb = 0, sb2 = 65536; bool wdone = false;
  const int lead = (wid < 4) ? 1 : 0;
  for (int i = 0; i < NS; ++i) {
    AWAIT_BAR(0);
    if (i > 0) {
      const u32x4 fa = *(const ALAS u32x4*)(flg + 8 * ((i - 1) & 1)), fb = *(const ALAS u32x4*)(flg + 8 * ((i - 1) & 1) + 4);
      if (((fa.x & fa.y) & (fa.z & fa.w) & (fb.x & fb.y) & (fb.z & fb.w)) != 0u) break;
    }
    if (i + 2 < NS) DMA_PAIR(NT - 5 - 2 * i, sb2);
    const int si = i + lead; const int sbl = lead ? ((sb == 65536) ? 0 : sb + 32768) : sb;
    if (si < NS && !wdone) { if (si < 2) STEP_BODY(true); else STEP_PIPE(); }
    { bool done_ = wdone || (si + 1 >= NS);
      if (!done_) {
        if (MODE == 0) done_ = __all(R > SKIP_L2);
        else { const float fe = *((const ALAS float*)(shm + LDS_FC) + (NT - 2 - 2 * si) * KVBLK - 1);
               done_ = __all(zb + fq2 - fe - mhat < -SKIP_L2); } }
      wdone = done_;
      if (lane == 0) flg[8 * (i & 1) + wid] = done_ ? 1u : 0u; }
    sb = (sb == 65536) ? 0 : sb + 32768; sb2 = (sb2 == 65536) ? 0 : sb2 + 32768;
  }
#undef STEP_BODY
#undef STEP_PIPE
  __builtin_amdgcn_s_setprio(0);
  AWAIT_BAR(0);
  int tid2 = tid; asm volatile("" : "+v"(tid2));
  const int lane2 = tid2 & 63, r32b = lane2 & 31, hib = lane2 >> 5;
  ALAS float* wsf2 = (ALAS float*)(shm + LDS_WS) + wid * 64;
  float rli[16];
  if (MODE == 1) {
    const float l = R + xhalf(R, hib);
    if (hib == 0) wsf2[32 + r32b] = l;
#pragma unroll
    for (int r = 0; r < 16; ++r) rli[r] = __builtin_amdgcn_rcpf(wsf2[32 + crow(r, hib)]);
  } else {
#pragma unroll
    for (int r = 0; r < 16; ++r) rli[r] = 1.f;
  }
  bf16_t* Ow = O + (rowbase + q0 + wid * QBLK) * DM + h * 64;
  { ALAS bf16_t* stg = (ALAS bf16_t*)(shm + LDS_OST) + wid * 2048;
#pragma unroll
    for (int r = 0; r < 16; ++r) { const int orow = crow(r, hib);
#pragma unroll
      for (int d0 = 0; d0 < 2; ++d0) { const unsigned pk = cvtpk_s(o[d0][r] * rli[r], 0.f); stg[orow * 64 + d0 * 32 + r32b] = (bf16_t)(pk & 0xffffu); } }
    asm volatile("s_waitcnt lgkmcnt(0)" ::: "memory");
#pragma unroll
    for (int i = 0; i < 4; ++i) { const int row = i * 8 + (lane2 >> 3), ch = lane2 & 7; const u32x4 v = *(const ALAS u32x4*)(stg + row * 64 + ch * 8); *(u32x4*)(Ow + (long)row * DM + ch * 8) = v; } }
  asm volatile("s_waitcnt lgkmcnt(0)\n\ts_barrier" ::: "memory");
#undef DMA_PAIR
}
template <int MODE> __device__ __forceinline__ void attn_phase(ALAS char* lds, const bf16_t* Q, const bf16_t* K, const bf16_t* V, bf16_t* O, const float* FC2, const float* kgain, unsigned* ctr) {
  ALAS unsigned* qw = (ALAS unsigned*)(lds + LDS_FLG) + 16;
  for (;;) {
    if (threadIdx.x == 0) *qw = __hip_atomic_fetch_add(ctr, 1u, __ATOMIC_RELAXED, __HIP_MEMORY_SCOPE_AGENT);
    __syncthreads();
    const unsigned u = *qw;
    if (u >= 1024u) break;
    const int qb = 31 - (int)(u >> 5), bh = (int)(u & 31u);
    attn_unit<MODE>(bh / NHEAD, bh % NHEAD, qb, Q, K, V, O, FC2, kgain, lds);
  }
}
template <bool BAND> __device__ __forceinline__ void sb_half(f32x16& p, float& R, int krel0, int hi) {
  f32x16 s;
#pragma unroll
  for (int r = 0; r < 16; ++r) { const float z = p[r]; const float u = __builtin_amdgcn_logf(1.0f + __builtin_amdgcn_exp2f(-__builtin_fabsf(z))); s[r] = __builtin_fmaf(0.5f, z + __builtin_fabsf(z), u); }
  if (BAND) {
#pragma unroll
    for (int r = 0; r < 16; ++r) { const int kr = krel0 + (r & 3) + 8 * (r >> 2); if (kr >= 0) s[r] = 0.f; } }
#pragma unroll
  for (int g = 0; g < 4; ++g) { s[4 * g + 2] += s[4 * g + 3]; s[4 * g + 1] += s[4 * g + 2]; s[4 * g] += s[4 * g + 1]; }
  float W[5]; W[4] = 0.f;
#pragma unroll
  for (int g = 3; g >= 0; --g) W[g] = W[g + 1] + s[4 * g];
  float base[4]; float tot0 = 0.f; const float Rold = R;
#pragma unroll
  for (int g = 0; g < 4; ++g) { auto rr = __builtin_amdgcn_permlane32_swap(__float_as_uint(W[g]), __float_as_uint(W[g + 1]), false, false);
    const float wp = __uint_as_float(hi ? rr[0] : rr[1]); base[g] = Rold + W[g + 1] + wp; if (g == 0) tot0 = W[0] + wp; }
  { const float pt = xhalf(tot0, hi); R = Rold + (hi ? pt : tot0); }
#pragma unroll
  for (int r = 0; r < 16; ++r) p[r] = __builtin_amdgcn_exp2f(p[r] - (base[r >> 2] + s[r]));
  if (BAND) {
#pragma unroll
    for (int r = 0; r < 16; ++r) { const int kr = krel0 + (r & 3) + 8 * (r >> 2); if (kr >= 0) p[r] = 0.f; } }
}
__device__ __forceinline__ void sb_wave_unit(int b, int h, int rb, const bf16_t* Q, const bf16_t* __restrict__ K, const bf16_t* __restrict__ V, bf16_t* O, ALAS char* wl) {
  int tid = threadIdx.x; asm volatile("" : "+v"(tid));
  const int lane = tid & 63, r32 = lane & 31, hi = lane >> 5;
  const long rowbase = (long)b * SEQ; const int r0 = rb * QBLK;
  const bf16_t* Qw = Q + (rowbase + r0) * DM + h * 64;
  const bf16_t *Kh = K + rowbase * DM + h * 64, *Vh = V + rowbase * DM + h * 64;
  const unsigned l0 = (unsigned)(uintptr_t)wl;
  const bf16_t* ksrc = Kh + (long)(lane >> 3) * DM + (((lane & 7) ^ ((lane >> 3) & 7)) * 8);
  const bf16_t* vsrc = Vh + (long)(lane >> 2) * DM + (lane & 3) * 8;
  const unsigned kq = l0 + r32 * 128 + ((hi ^ (r32 & 7)) << 4);
  const lds_cptr vp = (lds_cptr)wl + 8192 + ((lane >> 4) & 1) * 32 + (lane & 3) * 8 + (4 * hi + ((lane & 15) >> 2)) * 64;
  bf16x8 qr[4];
#pragma unroll
  for (int d0 = 0; d0 < 4; ++d0) qr[d0] = *reinterpret_cast<const bf16x8*>(&Qw[(long)r32 * DM + d0 * 16 + hi * 8]);
  f32x16 o[2]; o[0] = f32x16{}; o[1] = f32x16{}; float R = 0.f; const f32x16 zc = f32x16{};
  const int tdiag = (r0 + QBLK - 1) >> 6;
  for (int t = tdiag; t >= 0; --t) {
#pragma unroll
    for (int j = 0; j < 8; ++j) glds16(ksrc + (long)(64 * t + 8 * j) * DM, (unsigned)__builtin_amdgcn_readfirstlane(l0 + j * 1024));
#pragma unroll
    for (int p = 0; p < 8; ++p) glds16(vsrc + (long)(64 * t + 16 * (p & 3)) * DM + 32 * (p >> 2), (unsigned)__builtin_amdgcn_readfirstlane(l0 + 8192 + p * 1024));
    asm volatile("s_waitcnt vmcnt(0)" ::: "memory");
    f32x16 p0, p1; bf16x8 kf[8], vf[8], pa[4];
    kread8(kf, kq, 0); SBAR0(); qk8(p0, p1, kf, qr, zc);
    vread16(vf, vp); SBAR0();
    bool stop = false;
    if (t == tdiag) {
      if ((r0 & 32) == 0) { p1 = f32x16{}; sb_half<true>(p0, R, 64 * t - r0 + 4 * hi - r32, hi); }
      else { sb_half<true>(p1, R, 64 * t + 32 - r0 + 4 * hi - r32, hi); sb_half<false>(p0, R, 0, hi); }
    } else {
      sb_half<false>(p1, R, 0, hi);
      if (__all(R > SKIP_L2)) { p0 = f32x16{}; stop = true; } else sb_half<false>(p0, R, 0, hi);
    }
    pack4(pa, p0, p1); pv8(o, pa, vf);
    asm volatile("s_waitcnt lgkmcnt(0)" ::: "memory");
    if (stop || __all(R > SKIP_L2)) break;
  }
  { ALAS bf16_t* stg = (ALAS bf16_t*)wl;
#pragma unroll
    for (int r = 0; r < 16; ++r) { const int orow = crow(r, hi);
#pragma unroll
      for (int d0 = 0; d0 < 2; ++d0) { const unsigned pk = cvtpk_s(o[d0][r], 0.f); stg[orow * 64 + d0 * 32 + r32] = (bf16_t)(pk & 0xffffu); } }
    asm volatile("s_waitcnt lgkmcnt(0)" ::: "memory");
    bf16_t* Ow = O + (rowbase + r0) * DM + h * 64;
#pragma unroll
    for (int i = 0; i < 4; ++i) { const int row = i * 8 + (lane >> 3), ch = lane & 7; const u32x4 v = *(const ALAS u32x4*)(stg + row * 64 + ch * 8); *(u32x4*)(Ow + (long)row * DM + ch * 8) = v; }
    asm volatile("s_waitcnt lgkmcnt(0)" ::: "memory"); }
}
__device__ __forceinline__ void sb_wave_phase(ALAS char* lds, const bf16_t* Q, const bf16_t* K, const bf16_t* V, bf16_t* O, int G, int bx) {
  const int wid = __builtin_amdgcn_readfirstlane(threadIdx.x >> 6); ALAS char* wl = lds + wid * 16384;
  const int NWV = G * NW;
  for (int wu = bx * NW + wid; wu < 32 * 256 * 4 / 4 * 4 / 4; wu += NWV) {
    const int g = wu % 2048, j = wu / 2048; const int bh = (g >> 8) + 8 * j, rb = g & 255;
    sb_wave_unit(bh / NHEAD, bh % NHEAD, rb, Q, K, V, O, wl);
  }
}
}
constexpr int NWAVES = 8;
constexpr int BATCH = 2, T = 8192, D = 1024, H = 16, HD = 64, FF = 2816, M = BATCH * T;
constexpr float RMS_EPS = 1e-6f;
constexpr float LOG2E = 1.4426950408889634f;
constexpr float QSCALE = 0.125f * LOG2E;
#ifndef MK_PER_PHASE
#define MK_PER_PHASE 0
#endif
constexpr int N_PHASES = 15;
constexpr size_t MiB = 1u << 20;
constexpr size_t WS_CTL = 0;
constexpr size_t WS_MOD = 1 * MiB;
constexpr size_t WS_LOGF = 2 * MiB;
constexpr size_t WS_FC = 3 * MiB;
constexpr size_t WS_PART = 65536;
constexpr size_t WS_BIAS2 = 217 * MiB;
constexpr size_t WS_WQKV = 4 * MiB, WS_WO0 = 10 * MiB, WS_WIN0 = 12 * MiB, WS_WDN0 = 23 * MiB, WS_WKV = 29 * MiB, WS_WQ1 = 33 * MiB, WS_WO1 = 35 * MiB, WS_WIN1 = 37 * MiB, WS_WDN1 = 48 * MiB;
constexpr size_t WS_HA = 56 * MiB, WS_HQ = 88 * MiB;
constexpr size_t WS_Q = 120 * MiB, WS_K = 152 * MiB, WS_V = 184 * MiB;
constexpr size_t WS_ACT = 120 * MiB;
constexpr size_t WS_END = 218 * MiB;
static_assert(WS_WDN1 + (size_t)D * FF * 2 <= WS_HA && WS_ACT + (size_t)M * FF * 2 <= WS_BIAS2 && WS_WQ1 == WS_WKV + (size_t)2048 * D * 2 && WS_HQ == WS_HA + (size_t)M * D * 2, "d_ws map");
constexpr int RING_BYTES = 131072, LDS_BYTES = 147456;

#define LAS __attribute__((address_space(3)))
typedef unsigned short bf16;
typedef unsigned v4u __attribute__((ext_vector_type(4)));
typedef float f32x4 __attribute__((ext_vector_type(4)));
#define LDS_WAIT() asm volatile("s_waitcnt lgkmcnt(0)" ::: "memory")
__device__ __forceinline__ unsigned f2bf(float f) { unsigned u = __builtin_bit_cast(unsigned, f); return (u + 0x7fffu + ((u >> 16) & 1u)) >> 16; }
__device__ __forceinline__ unsigned pk2(float lo, float hi) { return f2bf(lo) | (f2bf(hi) << 16); }
__device__ __forceinline__ float wave_sum(float v) {
#pragma unroll
    for (int o = 1; o < 64; o <<= 1) v += __shfl_xor(v, o);
    return v;
}
struct Args { const float* in[19]; float* out; unsigned char* ws; int ph_lo, ph_hi; };

__device__ __forceinline__ void transpose_item(const float* W, int ldw, bf16* WT, int Kd, int drow0, int k0, int n0, LAS float* scr, int lane) {
    float tv[32];
#pragma unroll
    for (int i = 0; i < 32; ++i) { const int kk = 2 * i + (lane >> 5); tv[i] = W[(size_t)(k0 + kk) * ldw + n0 + (lane & 31)]; }
#pragma unroll
    for (int i = 0; i < 32; ++i) { const int kk = 2 * i + (lane >> 5); scr[kk * 33 + (lane & 31)] = tv[i]; }
    LDS_WAIT(); asm volatile("" ::: "memory");
    const int c = lane & 7;
#pragma unroll
    for (int j = 0; j < 4; ++j) { const int n = (lane >> 3) + 8 * j; const LAS float* s = scr + (8 * c) * 33 + n;
        v4u o; o.x = pk2(s[0 * 33], s[1 * 33]); o.y = pk2(s[2 * 33], s[3 * 33]); o.z = pk2(s[4 * 33], s[5 * 33]); o.w = pk2(s[6 * 33], s[7 * 33]);
        *(v4u*)(WT + (size_t)(drow0 + n) * Kd + k0 + 8 * c) = o; }
    LDS_WAIT(); asm volatile("" ::: "memory");
}
__device__ __forceinline__ int row_map(int kind, int n0) {
    if (kind == 1) { const int up = n0 >= FF; const int j = up ? n0 - FF : n0; return 256 * (j >> 7) + (up ? 128 : 0) + (j & 127); }
    if (kind == 2 && n0 < 1024) { const int p = n0 >> 8, w = (n0 >> 6) & 3, jj = (n0 >> 5) & 1; return 256 * p + 128 * jj + 32 * w; }
    return n0;
}
__device__ __forceinline__ void transpose_weights(const Args& a, LAS unsigned char* lds, int lane, int w, int nw, int mat_lo, int mat_hi) {
    LAS float* scr = (LAS float*)(lds + (threadIdx.x >> 6) * 16384);
    for (int it = w; ; it += nw) {
        int r = it, mi = mat_lo; const float* W = nullptr; int ldw = 0, ncb = 0, Kd = 0, kind = 0; bf16* WT = nullptr;
        for (; mi < mat_hi; ++mi) {
            switch (mi) {
                case 0: W = a.in[8]; ldw = 3 * D; ncb = 96; Kd = D; kind = 0; WT = (bf16*)(a.ws + WS_WQKV); break;
                case 1: W = a.in[9]; ldw = D; ncb = 32; Kd = D; kind = 0; WT = (bf16*)(a.ws + WS_WO0); break;
                case 2: W = a.in[6]; ldw = 2 * FF; ncb = 176; Kd = D; kind = 1; WT = (bf16*)(a.ws + WS_WIN0); break;
                case 3: W = a.in[7]; ldw = D; ncb = 32; Kd = FF; kind = 0; WT = (bf16*)(a.ws + WS_WDN0); break;
                case 4: W = a.in[13]; ldw = 2 * D + H; ncb = 64; Kd = D; kind = 2; WT = (bf16*)(a.ws + WS_WKV); break;
                case 5: W = a.in[16]; ldw = D; ncb = 32; Kd = D; kind = 2; WT = (bf16*)(a.ws + WS_WQ1); break;
                case 6: W = a.in[18]; ldw = D; ncb = 32; Kd = D; kind = 0; WT = (bf16*)(a.ws + WS_WO1); break;
                case 7: W = a.in[6] + (size_t)D * 2 * FF; ldw = 2 * FF; ncb = 176; Kd = D; kind = 1; WT = (bf16*)(a.ws + WS_WIN1); break;
                default: W = a.in[7] + (size_t)FF * D; ldw = D; ncb = 32; Kd = FF; kind = 0; WT = (bf16*)(a.ws + WS_WDN1); break;
            }
            const int items = (Kd / 64) * ncb; if (r < items) break; r -= items;
        }
        if (mi >= mat_hi) break;
        const int kb = r / ncb, nb = r % ncb;
        transpose_item(W, ldw, WT, Kd, row_map(kind, 32 * nb), 64 * kb, 32 * nb, scr, lane);
    }
}
__device__ __forceinline__ void prologue(const Args& a, LAS unsigned char* lds, int tid, int lane, int wave, int G) {
    const int bx = blockIdx.x;
    float* mod = (float*)(a.ws + WS_MOD);
    if (bx < 224) {
        LAS float* ca = (LAS float*)lds; LAS float* red = (LAS float*)(lds + 8192);
        for (int i = tid; i < 2 * D; i += 512) { const float v = a.in[1][i]; ca[i] = v / (1.f + __expf(-v)); }
        __syncthreads();
        const float* W; int N, col0; const float* bias; float* dst; int dstride;
        if (bx < 96) { W = a.in[2]; N = 6 * D; col0 = 64 * bx; bias = a.in[3] + col0; dst = mod + col0; dstride = 6 * D; }
        else if (bx < 192) { W = a.in[2] + (size_t)D * 6 * D; N = 6 * D; col0 = 64 * (bx - 96); bias = a.in[3] + 6 * D + col0; dst = mod + 2 * 6 * D + col0; dstride = 6 * D; }
        else { W = a.in[10]; N = 2 * D; col0 = 64 * (bx - 192); bias = a.in[11] + col0; dst = mod + 4 * 6 * D + col0; dstride = 2 * D; }
        const int rg = lane >> 4, cq = lane & 15; f32x4 a0 = {0.f, 0.f, 0.f, 0.f}, a1 = {0.f, 0.f, 0.f, 0.f}; const float* wp = W + (size_t)(128 * wave + rg) * N + col0 + 4 * cq;
#pragma unroll
        for (int h2 = 0; h2 < 2; ++h2) { f32x4 wv[16];
#pragma unroll
            for (int k = 0; k < 16; ++k) wv[k] = *(const f32x4*)(wp + (size_t)(4 * (16 * h2 + k)) * N);
#pragma unroll
            for (int k = 0; k < 16; ++k) { const int kr = 128 * wave + 4 * (16 * h2 + k) + rg; a0 += wv[k] * ca[kr]; a1 += wv[k] * ca[D + kr]; } }
#pragma unroll
        for (int e = 0; e < 4; ++e) { a0[e] += __shfl_xor(a0[e], 16); a0[e] += __shfl_xor(a0[e], 32); a1[e] += __shfl_xor(a1[e], 16); a1[e] += __shfl_xor(a1[e], 32); }
        if (rg == 0) { *(LAS f32x4*)(red + (wave * 2 + 0) * 64 + 4 * cq) = a0; *(LAS f32x4*)(red + (wave * 2 + 1) * 64 + 4 * cq) = a1; }
        __syncthreads();
        if (tid < 128) { const int b = tid >> 6, c = tid & 63; float s = 0.f;
#pragma unroll
            for (int w = 0; w < 8; ++w) s += red[(w * 2 + b) * 64 + c];
            dst[(size_t)b * dstride + c] = s + bias[c]; }
        __syncthreads();
    }
    transpose_weights(a, lds, lane, bx * NWAVES + wave, G * NWAVES, 0, 4);
}
__device__ __forceinline__ void norm_phase(const float* x, bf16* out, const float* g, const float* shift, const float* scale, int bstride, int gw, int NGW, int lane) {
    constexpr int NR = 4; f32x4 ca[4], cs[4]; int curb = -1;
    for (int m0 = gw; m0 < M; m0 += NR * NGW) {
        f32x4 v[NR][4]; float s[NR];
#pragma unroll
        for (int r = 0; r < NR; ++r) { const int m = m0 + r * NGW; if (m < M) { const f32x4* xr = (const f32x4*)(x + (size_t)m * D) + lane;
#pragma unroll
            for (int j = 0; j < 4; ++j) v[r][j] = xr[64 * j]; } }
#pragma unroll
        for (int r = 0; r < NR; ++r) { s[r] = 0.f; if (m0 + r * NGW < M) {
#pragma unroll
            for (int j = 0; j < 4; ++j) s[r] += (v[r][j].x * v[r][j].x + v[r][j].y * v[r][j].y) + (v[r][j].z * v[r][j].z + v[r][j].w * v[r][j].w); } }
#pragma unroll
        for (int o = 1; o < 64; o <<= 1)
#pragma unroll
            for (int r = 0; r < NR; ++r) s[r] += __shfl_xor(s[r], o);
#pragma unroll
        for (int r = 0; r < NR; ++r) { const int m = m0 + r * NGW; if (m < M) {
            const int b = m >> 13;
            if (b != curb) { curb = b;
#pragma unroll
                for (int j = 0; j < 4; ++j) { const int c = 256 * j + 4 * lane; ca[j] = *(const f32x4*)(g + c) * (1.0f + *(const f32x4*)(scale + (size_t)b * bstride + c)); cs[j] = *(const f32x4*)(shift + (size_t)b * bstride + c); } }
            const float rstd = 1.0f / sqrtf(s[r] * (1.f / D) + RMS_EPS);
            unsigned long long* o8 = (unsigned long long*)(out + (size_t)m * D) + lane;
#pragma unroll
            for (int j = 0; j < 4; ++j) { const f32x4 y = v[r][j] * rstd * ca[j] + cs[j]; o8[64 * j] = (unsigned long long)pk2(y.x, y.y) | ((unsigned long long)pk2(y.z, y.w) << 32); } } }
    }
}
__device__ __forceinline__ void bias2_phase(unsigned char* ws, int gw, int NGW, int lane, int layer) {
    const float* mod = (const float*)(ws + WS_MOD); float* b2 = (float*)(ws + WS_BIAS2);
    constexpr int NB = 6; v4u w0[NB], w1[NB];
    for (int it0 = gw + layer * 5632; it0 < (layer + 1) * 5632; it0 += NB * NGW) {
#pragma unroll
        for (int j = 0; j < NB; ++j) { const int it = it0 + j * NGW; if (it < (layer + 1) * 5632) { const int l = it / 5632, rho = it % 5632; const bf16* wrow = (const bf16*)(ws + (l ? WS_WIN1 : WS_WIN0)) + (size_t)rho * D + 16 * lane;
            w0[j] = *(const v4u*)wrow; w1[j] = *(const v4u*)(wrow + 8); } }
#pragma unroll
        for (int j = 0; j < NB; ++j) { const int it = it0 + j * NGW; if (it < (layer + 1) * 5632) { const int l = it / 5632, rho = it % 5632;
            const unsigned wu[8] = {w0[j].x, w0[j].y, w0[j].z, w0[j].w, w1[j].x, w1[j].y, w1[j].z, w1[j].w};
            float a0 = 0.f, a1 = 0.f; const float* s0 = mod + (size_t)(l * 2 + 0) * 6 * D + 3 * D + 16 * lane; const float* s1 = s0 + 6 * D;
#pragma unroll
            for (int k = 0; k < 8; ++k) { const float lo = __uint_as_float(wu[k] << 16), hi = __uint_as_float(wu[k] & 0xffff0000u);
                a0 += s0[2 * k] * lo + s0[2 * k + 1] * hi; a1 += s1[2 * k] * lo + s1[2 * k + 1] * hi; }
            a0 = wave_sum(a0); a1 = wave_sum(a1);
            if (lane == 0) { b2[(size_t)(l * 2 + 0) * 5632 + rho] = a0; b2[(size_t)(l * 2 + 1) * 5632 + rho] = a1; } } }
    }
}
__device__ __forceinline__ void norm2_phase(const Args& a, LAS unsigned char* lds, int tid, int gw, int NGW, int lane) {
    const float* x = a.out; bf16* hK = (bf16*)(a.ws + WS_HA); bf16* hQ = (bf16*)(a.ws + WS_HQ); float* logf_out = (float*)(a.ws + WS_LOGF);
    const float* mod1 = (const float*)(a.ws + WS_MOD) + 2 * 6 * D; const float* kvmod = (const float*)(a.ws + WS_MOD) + 4 * 6 * D;
    LAS float* wf = (LAS float*)lds;
    { const float* Wf = a.in[13] + 2 * D; for (int k = tid; k < D; k += 512) { const float* src = Wf + (size_t)k * (2 * D + H);
#pragma unroll
        for (int c = 0; c < 16; ++c) wf[c * D + k] = src[c]; } }
    __syncthreads();
    f32x4 ka[4], ks[4], qa[4], qs[4]; int curb = -1; f32x4 vn[4], vn2[4];
    if (gw < M) { const f32x4* xr = (const f32x4*)(x + (size_t)gw * D) + lane;
#pragma unroll
        for (int j = 0; j < 4; ++j) vn[j] = xr[64 * j]; }
    if (gw + NGW < M) { const f32x4* xr = (const f32x4*)(x + (size_t)(gw + NGW) * D) + lane;
#pragma unroll
        for (int j = 0; j < 4; ++j) vn2[j] = xr[64 * j]; }
    for (int m = gw; m < M; m += NGW) {
        const int b = m >> 13;
        if (b != curb) { curb = b;
#pragma unroll
            for (int j = 0; j < 4; ++j) { const int c = 256 * j + 4 * lane;
                ka[j] = *(const f32x4*)(a.in[12] + c) * (1.0f + *(const f32x4*)(kvmod + b * 2 * D + D + c)); ks[j] = *(const f32x4*)(kvmod + b * 2 * D + c);
                qa[j] = *(const f32x4*)(a.in[4] + D + c) * (1.0f + *(const f32x4*)(mod1 + b * 6 * D + D + c)); qs[j] = *(const f32x4*)(mod1 + b * 6 * D + c); } }
        f32x4 v[4]; float s = 0.f;
#pragma unroll
        for (int j = 0; j < 4; ++j) { v[j] = vn[j]; vn[j] = vn2[j]; s += (v[j].x * v[j].x + v[j].y * v[j].y) + (v[j].z * v[j].z + v[j].w * v[j].w); }
        if (m + 2 * NGW < M) { const f32x4* xr = (const f32x4*)(x + (size_t)(m + 2 * NGW) * D) + lane;
#pragma unroll
            for (int j = 0; j < 4; ++j) vn2[j] = xr[64 * j]; }
        const float rstd = 1.0f / sqrtf(wave_sum(s) * (1.f / D) + RMS_EPS);
        unsigned long long* ok = (unsigned long long*)(hK + (size_t)m * D) + lane; unsigned long long* oq = (unsigned long long*)(hQ + (size_t)m * D) + lane;
        f32x4 yk[4];
#pragma unroll
        for (int j = 0; j < 4; ++j) { const f32x4 xn = v[j] * rstd; yk[j] = xn * ka[j] + ks[j]; const f32x4 yq = xn * qa[j] + qs[j];
            ok[64 * j] = (unsigned long long)pk2(yk[j].x, yk[j].y) | ((unsigned long long)pk2(yk[j].z, yk[j].w) << 32);
            oq[64 * j] = (unsigned long long)pk2(yq.x, yq.y) | ((unsigned long long)pk2(yq.z, yq.w) << 32); }
        float part[16];
#pragma unroll
        for (int cg = 0; cg < 4; ++cg) {
#pragma unroll
            for (int c4 = 0; c4 < 4; ++c4) { const int c = 4 * cg + c4; float p = 0.f;
#pragma unroll
                for (int j = 0; j < 4; ++j) { const f32x4 w = *(const LAS f32x4*)(wf + c * D + 256 * j + 4 * lane); p += (yk[j].x * w.x + yk[j].y * w.y) + (yk[j].z * w.z + yk[j].w * w.w); }
                part[c] = p; }
            asm volatile("" ::: "memory");
        }
        float q8[8], q4[4], q2[2], q1;
        { const bool up = (lane & 32) != 0;
#pragma unroll
          for (int c = 0; c < 8; ++c) { const float keep = up ? part[c + 8] : part[c], send = up ? part[c] : part[c + 8]; q8[c] = keep + __shfl_xor(send, 32); } }
        { const bool up = (lane & 16) != 0;
#pragma unroll
          for (int c = 0; c < 4; ++c) { const float keep = up ? q8[c + 4] : q8[c], send = up ? q8[c] : q8[c + 4]; q4[c] = keep + __shfl_xor(send, 16); } }
        { const bool up = (lane & 8) != 0;
#pragma unroll
          for (int c = 0; c < 2; ++c) { const float keep = up ? q4[c + 2] : q4[c], send = up ? q4[c] : q4[c + 2]; q2[c] = keep + __shfl_xor(send, 8); } }
        { const bool up = (lane & 4) != 0; const float keep = up ? q2[1] : q2[0], send = up ? q2[0] : q2[1]; q1 = keep + __shfl_xor(send, 4); }
        q1 += __shfl_xor(q1, 2); q1 += __shfl_xor(q1, 1);
        if ((lane & 3) == 0) { const int c = ((lane >> 5) & 1) * 8 + ((lane >> 4) & 1) * 4 + ((lane >> 3) & 1) * 2 + ((lane >> 2) & 1);
            const float y = q1 + a.in[14][c]; const float lf = -(fmaxf(-y, 0.f) + log1pf(expf(-fabsf(y)))); logf_out[((size_t)b * H + c) * T + (m & (T - 1))] = lf; }
    }
    __syncthreads();
}
__device__ __forceinline__ void scan_seq(const float* src, float* dst, LAS unsigned char* lds, int tid, int lane, int wave) {
    LAS float* wt = (LAS float*)lds;
    f32x4 v[4]; const f32x4* s4 = (const f32x4*)(src + 16 * tid);
#pragma unroll
    for (int j = 0; j < 4; ++j) v[j] = s4[j];
    float run = 0.f;
#pragma unroll
    for (int j = 0; j < 4; ++j) { v[j].x += run; v[j].y += v[j].x; v[j].z += v[j].y; v[j].w += v[j].z; run = v[j].w; }
    float xs = run;
#pragma unroll
    for (int off = 1; off < 64; off <<= 1) { const float y = __shfl_up(xs, off); if (lane >= off) xs += y; }
    if (lane == 63) wt[wave] = xs;
    __syncthreads();
    float woff = 0.f;
#pragma unroll
    for (int w = 0; w < 8; ++w) woff += (w < wave) ? wt[w] : 0.f;
    const float offs = woff + xs - run;
    f32x4* d4 = (f32x4*)(dst + 16 * tid);
#pragma unroll
    for (int j = 0; j < 4; ++j) d4[j] = (v[j] + offs) * LOG2E;
    __syncthreads();
}

#define XB_TMO      128
#define XB_XCNT(j)  (256  + 64 * (j))
#define XB_XSUB(j)  (1280 + 64 * (j))
#define XB_XGEN(j)  (2304 + 64 * (j))
#define XB_TOP      3328
#define XB_TOPGEN   3392
#define XCD_BAR_WORDS 3456
#define XB_SPIN_CAP (1u << 18)

__device__ __forceinline__ unsigned xb_ld(unsigned* p)              { return __hip_atomic_load(p, __ATOMIC_RELAXED, __HIP_MEMORY_SCOPE_AGENT); }
__device__ __forceinline__ unsigned xb_add(unsigned* p, unsigned v) { return __hip_atomic_fetch_add(p, v, __ATOMIC_RELAXED, __HIP_MEMORY_SCOPE_AGENT); }
__device__ __forceinline__ unsigned xb_xcc_id() { return (unsigned)__builtin_amdgcn_s_getreg((3 << 11) | 20) & 0xFu; }
#define XB_SPIN(cond, bar) do { unsigned _sp = 0; while (cond) { __builtin_amdgcn_s_sleep(1); \
    if ((++_sp & 255u) == 0u) { if (xb_ld(&(bar)[XB_TMO])) break; if (_sp > XB_SPIN_CAP) { atomicAdd(&(bar)[XB_TMO], 1u); break; } } } } while (0)

struct XcdBarrier {
    unsigned* bar; unsigned x;
    volatile LAS unsigned* st;
};

__device__ __forceinline__ XcdBarrier xcd_barrier_post(unsigned* bar, volatile LAS unsigned* st) {
    XcdBarrier b; b.bar = bar; b.x = xb_xcc_id(); b.st = st;
    if (threadIdx.x == 0) (void)xb_add(&bar[XB_XCNT(b.x)], 1u);
    return b;
}
__device__ __forceinline__ void xcd_barrier_complete(unsigned* bar, unsigned x, unsigned& nloc, unsigned& nx) {
    const unsigned G = gridDim.x * gridDim.y * gridDim.z;
    unsigned sum, cnt, mine, sp = 0u;
    for (;;) {
        sum = 0u; cnt = 0u; mine = 0u;
#pragma unroll
        for (unsigned j = 0; j < 16; ++j) { const unsigned c = xb_ld(&bar[XB_XCNT(j)]); sum += c; cnt += (c > 0u) ? 1u : 0u; mine = (j == x) ? c : mine; }
        if (sum == G) break;
        __builtin_amdgcn_s_sleep(1);
        if ((++sp & 255u) == 0u) { if (xb_ld(&bar[XB_TMO])) break; if (sp > XB_SPIN_CAP) { atomicAdd(&bar[XB_TMO], 1u); break; } }
    }
    nloc = mine > 0u ? mine : 1u; nx = cnt > 0u ? cnt : 1u;
}

__device__ __forceinline__ void xcd_barrier(const XcdBarrier& b) {
    asm volatile("s_waitcnt vmcnt(0)" ::: "memory");
    __syncthreads();
    if (threadIdx.x == 0) {
        unsigned* bar = b.bar;
        __builtin_amdgcn_s_waitcnt(0);
        unsigned nloc = b.st[0], nx = b.st[1];
        if (nloc == 0u) { xcd_barrier_complete(bar, b.x, nloc, nx); b.st[0] = nloc; b.st[1] = nx; }
        const unsigned old = xb_add(&bar[XB_XSUB(b.x)], 1u);
        const unsigned gen = old / nloc;
        if (old + 1u == (gen + 1u) * nloc) {
            __builtin_amdgcn_fence(__ATOMIC_RELEASE, "agent");
            asm volatile("s_waitcnt vmcnt(0)" ::: "memory");
            const unsigned og = xb_add(&bar[XB_TOP], 1u);
            const unsigned tg = og / nx;
            if (og + 1u == (tg + 1u) * nx) xb_add(&bar[XB_TOPGEN], 1u);
            else XB_SPIN(xb_ld(&bar[XB_TOPGEN]) == tg, bar);
            __builtin_amdgcn_fence(__ATOMIC_ACQUIRE, "agent");
            xb_add(&bar[XB_XGEN(b.x)], 1u);
            asm volatile("s_waitcnt vmcnt(0)" ::: "memory");
        } else {
            XB_SPIN(xb_ld(&bar[XB_XGEN(b.x)]) == gen, bar);
            __builtin_amdgcn_fence(__ATOMIC_ACQUIRE, "agent");
            asm volatile("s_waitcnt vmcnt(0)" ::: "memory");
        }
    }
    __syncthreads();
}


constexpr int CW_BAR = 4096;
constexpr size_t CTL_ZERO_BYTES = 65536 + 2 * 16384 * 4;
__global__ void __launch_bounds__(NWAVES * 64, 2) yoco_fwd(Args args) {
    extern __shared__ __attribute__((aligned(16))) unsigned char lds_raw[];
    LAS unsigned char* lds = (LAS unsigned char*)lds_raw;
    const int tid = threadIdx.x, lane = tid & 63, wave = __builtin_amdgcn_readfirstlane(tid >> 6);
    const int G = gridDim.x, bx = blockIdx.x; const int gw = bx * NWAVES + wave, NGW = G * NWAVES;
    unsigned char* ws = args.ws;
    const float* mod = (const float*)(ws + WS_MOD);
    bf16 *hA = (bf16*)(ws + WS_HA), *hQb = (bf16*)(ws + WS_HQ), *Qb = (bf16*)(ws + WS_Q), *Kb = (bf16*)(ws + WS_K), *Vb = (bf16*)(ws + WS_V), *ACT = (bf16*)(ws + WS_ACT);
    const int lo = args.ph_lo, hi = args.ph_hi;
#define LANE() ({ int l_ = tid & 63; asm volatile("" : "+v"(l_)); l_; })
#ifndef RPT_MASK
#define RPT_MASK 0
#endif
#ifndef PH_MASK
#define PH_MASK 0x7fff
#endif
#define IN(k) (((PH_MASK >> (k)) & 1) && lo <= (k) && (k) < hi)
    { volatile LAS unsigned* st = (volatile LAS unsigned*)(lds + LDS_BYTES - 64); if (tid < 4) st[tid] = 0u; }
    __syncthreads();
    XcdBarrier bar = xcd_barrier_post((unsigned*)(ws + WS_CTL) + CW_BAR, (volatile LAS unsigned*)(lds + LDS_BYTES - 64));
    if (args.ph_hi > 1000) cg::this_grid().sync();
#define SEAM(k) do { if (IN(k) && (k) + 1 < hi) xcd_barrier(bar); } while (0)
    if (IN(0)) { for (int rep_ = 0; rep_ <= ((RPT_MASK >> 0) & 1); ++rep_) { if (rep_) xcd_barrier(bar); prologue(args, lds, tid, LANE(), wave, G); } } SEAM(0);
    if (IN(1)) { for (int rep_ = 0; rep_ <= ((RPT_MASK >> 1) & 1); ++rep_) { if (rep_) xcd_barrier(bar); norm_phase(args.in[0], hA, args.in[4], mod, mod + D, 6 * D, gw, NGW, LANE()); bias2_phase(ws, gw, NGW, LANE(), 0); } } SEAM(1);
    if (IN(2)) { for (int rep_ = 0; rep_ <= ((RPT_MASK >> 2) & 1); ++rep_) { if (rep_) xcd_barrier(bar); pg8::Gemm g{hA, (const bf16*)(ws + WS_WQKV), M, 3 * D, D}; pg8::StaticOrder S; S.init(M, 3 * D, G, bx);
        pg8::EpiQKV E{Qb, (size_t)(WS_K - WS_Q) / 2, QSCALE}; pg8::gemm_phase<pg8::EpiQKV, pg8::StaticOrder, true, true>(lds, g, S, E); } } SEAM(2);
    if (IN(3)) { for (int rep_ = 0; rep_ <= ((RPT_MASK >> 3) & 1); ++rep_) { if (rep_) xcd_barrier(bar); att::sb_wave_phase((ALAS char*)lds, Qb, Kb, Vb, hA, G, bx); } } SEAM(3);
    if (IN(4)) { for (int rep_ = 0; rep_ <= ((RPT_MASK >> 4) & 1); ++rep_) { if (rep_) xcd_barrier(bar); pg8::Gemm g{hA, (const bf16*)(ws + WS_WO0), M, D, D}; pg8::StaticOrder S; S.init(M, D, G, bx);
        pg8::EpiResN E{args.in[0], args.out, mod + 2 * D, 6 * D, hQb, args.in[5], mod + 4 * D, (float*)(ws + WS_PART)}; pg8::gemm_phase<pg8::EpiResN, pg8::StaticOrder, true, true>(lds, g, S, E); } } SEAM(4);
    if (IN(6)) { for (int rep_ = 0; rep_ <= ((RPT_MASK >> 6) & 1); ++rep_) { if (rep_) xcd_barrier(bar); pg8::Gemm g{hQb, (const bf16*)(ws + WS_WIN0), M, 2 * FF, D}; const unsigned ldsx = (unsigned)(uintptr_t)(lds + RING_BYTES);
        pg8::SwiOrder S{{}, (const float*)(ws + WS_PART), (const float*)(ws + WS_BIAS2), ldsx, 0}; S.so.init(M, 2 * FF, G, bx);
        pg8::EpiSwiGLU E{ACT, ldsx, RMS_EPS, 0}; pg8::gemm_phase<pg8::EpiSwiGLU, pg8::SwiOrder, true, true>(lds, g, S, E);
        if (G == 256) { if (bx >= 128) transpose_weights(args, lds, LANE(), (bx - 128) * NWAVES + wave, 128 * NWAVES, 4, 9); } else transpose_weights(args, lds, LANE(), gw, NGW, 4, 9); } } SEAM(6);
    if (IN(7)) { for (int rep_ = 0; rep_ <= ((RPT_MASK >> 7) & 1); ++rep_) { if (rep_) xcd_barrier(bar); pg8::Gemm g{ACT, (const bf16*)(ws + WS_WDN0), M, D, FF}; pg8::StaticOrder S; S.init(M, D, G, bx);
        pg8::EpiRes E{args.out, args.out, mod + 5 * D, 6 * D}; pg8::gemm_phase<pg8::EpiRes, pg8::StaticOrder, true, true>(lds, g, S, E); } } SEAM(7);
    if (IN(8)) { for (int rep_ = 0; rep_ <= ((RPT_MASK >> 8) & 1); ++rep_) { if (rep_) xcd_barrier(bar); norm2_phase(args, lds, tid, gw, NGW, LANE()); bias2_phase(ws, gw, NGW, LANE(), 1); } } SEAM(8);
    if (IN(9)) { for (int rep_ = 0; rep_ <= ((RPT_MASK >> 9) & 1); ++rep_) { if (rep_) xcd_barrier(bar);
        if (bx < BATCH * H) scan_seq((const float*)(ws + WS_LOGF) + (size_t)bx * T, (float*)(ws + WS_FC) + (size_t)bx * T, lds, tid, LANE(), wave);
        pg8::Gemm g{hA, (const bf16*)(ws + WS_WKV), 2 * M, 3 * D, D}; pg8::StackOrder S{G, bx};
        pg8::EpiKVQ E{Kb, Vb, Qb, args.in[15], args.in[17], QSCALE, RMS_EPS}; pg8::gemm_phase<pg8::EpiKVQ, pg8::StackOrder, true, true>(lds, g, S, E); } } SEAM(9);
    if (IN(10)) { for (int rep_ = 0; rep_ <= ((RPT_MASK >> 10) & 1); ++rep_) { if (rep_) xcd_barrier(bar); att::attn_phase<1>((ALAS char*)lds, Qb, Kb, Vb, hA, (const float*)(ws + WS_FC), args.in[15], (unsigned*)(ws + WS_CTL) + 64 + 128 * rep_); } } SEAM(10);
    if (IN(11)) { for (int rep_ = 0; rep_ <= ((RPT_MASK >> 11) & 1); ++rep_) { if (rep_) xcd_barrier(bar); pg8::Gemm g{hA, (const bf16*)(ws + WS_WO1), M, D, D}; pg8::StaticOrder S; S.init(M, D, G, bx);
        pg8::EpiResN E{args.out, args.out, mod + 2 * 6 * D + 2 * D, 6 * D, hQb, args.in[5] + D, mod + 2 * 6 * D + 4 * D, (float*)(ws + WS_PART) + M}; pg8::gemm_phase<pg8::EpiResN, pg8::StaticOrder, true, true>(lds, g, S, E); } } SEAM(11);
    if (IN(13)) { for (int rep_ = 0; rep_ <= ((RPT_MASK >> 13) & 1); ++rep_) { if (rep_) xcd_barrier(bar); pg8::Gemm g{hQb, (const bf16*)(ws + WS_WIN1), M, 2 * FF, D}; const unsigned ldsx = (unsigned)(uintptr_t)(lds + RING_BYTES);
        pg8::SwiOrder S{{}, (const float*)(ws + WS_PART) + M, (const float*)(ws + WS_BIAS2) + 2 * 5632, ldsx, 0}; S.so.init(M, 2 * FF, G, bx);
        pg8::EpiSwiGLU E{ACT, ldsx, RMS_EPS, 0}; pg8::gemm_phase<pg8::EpiSwiGLU, pg8::SwiOrder, true, true>(lds, g, S, E); } } SEAM(13);
    if (IN(14)) { for (int rep_ = 0; rep_ <= ((RPT_MASK >> 14) & 1); ++rep_) { if (rep_) xcd_barrier(bar); pg8::Gemm g{ACT, (const bf16*)(ws + WS_WDN1), M, D, FF}; pg8::StaticOrder S; S.init(M, D, G, bx);
        pg8::EpiRes E{args.out, args.out, mod + 2 * 6 * D + 5 * D, 6 * D}; pg8::gemm_phase<pg8::EpiRes, pg8::StaticOrder, true, true>(lds, g, S, E); } }
#undef IN
#undef SEAM
}

extern "C" void kernel_launch(void* const* d_in, const int* in_sizes, int n_in, void* d_out, int out_size, void* d_ws, size_t ws_size, hipStream_t stream) {
    static int grid = 0;
    if (grid == 0) {
        if (n_in != 19 || out_size != M * D || ws_size < WS_END) { fprintf(stderr, "kernel_launch: unexpected shapes (n_in %d, out %d, ws %zu)\n", n_in, out_size, ws_size); grid = -1; return; }
        int dev = 0, cus = 0, per_cu = 0;
        (void)hipGetDevice(&dev); (void)hipDeviceGetAttribute(&cus, hipDeviceAttributeMultiprocessorCount, dev);
        if (hipFuncSetAttribute((const void*)yoco_fwd, hipFuncAttributeMaxDynamicSharedMemorySize, LDS_BYTES) != hipSuccess) { fprintf(stderr, "kernel_launch: hipFuncSetAttribute failed\n"); grid = -1; return; }
        if (hipOccupancyMaxActiveBlocksPerMultiprocessor(&per_cu, (const void*)yoco_fwd, NWAVES * 64, LDS_BYTES) != hipSuccess || per_cu < 1) { fprintf(stderr, "kernel_launch: occupancy query says %d\n", per_cu); per_cu = 1; }
        (void)hipGetLastError();
        grid = cus;
    }
    if (grid < 0) return;
    if (hipMemsetAsync((char*)d_ws + WS_CTL, 0, CTL_ZERO_BYTES, stream) != hipSuccess) { fprintf(stderr, "kernel_launch: memset failed\n"); return; }
    Args a{};
    for (int i = 0; i < 19; ++i) a.in[i] = (const float*)d_in[i];
    a.out = (float*)d_out; a.ws = (unsigned char*)d_ws;
#if MK_PER_PHASE
    for (int p = 0; p < N_PHASES; ++p) { a.ph_lo = p; a.ph_hi = p + 1; hipLaunchKernelGGL(yoco_fwd, dim3(grid), dim3(NWAVES * 64), LDS_BYTES, stream, a); }
#else
    a.ph_lo = 0; a.ph_hi = N_PHASES;
    void* kargs[] = {&a};
    const hipError_t e = hipLaunchCooperativeKernel((const void*)yoco_fwd, dim3(grid), dim3(NWAVES * 64), kargs, LDS_BYTES, stream);
    if (e != hipSuccess) fprintf(stderr, "kernel_launch: cooperative launch failed: %s (grid %d)\n", hipGetErrorString(e), grid);
#endif
}
```

```cpp
#include <hip/hip_runtime.h>
#include <hip/hip_cooperative_groups.h>
#include <cstdio>
#include <cstdint>
namespace cg = cooperative_groups;
namespace pg8 {
#define PG8_LAS __attribute__((address_space(3)))
typedef unsigned short bf16_t;
typedef short bf16x8 __attribute__((ext_vector_type(8)));
typedef float f32x4 __attribute__((ext_vector_type(4)));
typedef unsigned u32x4 __attribute__((ext_vector_type(4)));
constexpr int BM = 256, BK = 64, HALF = 128, HTB = HALF * BK * 2  , STAGE_BYTES = 8 * HTB, NXCD = 8, WGM = 8;

__host__ __device__ __forceinline__ int lds_byte(int r, int c) { const int st = (r >> 4) * 2 + (c >> 5), rr = r & 15, cc = c & 31, ob = rr * 64 + cc * 2; return st * 1024 + (ob ^ (((ob >> 9) & 1) << 5)); }
__host__ __device__ __forceinline__ void stage_rc(int b, int& R, int& C) { const int st = b / 1024, sb = b % 1024, swz = sb ^ (((sb >> 9) & 1) << 5); R = (st >> 1) * 16 + swz / 64; C = (st & 1) * 32 + (swz % 64) / 2; }
__host__ __device__ __forceinline__ int perm32(int rho) { const int n = rho >> 4, i = rho & 15; return 8 * (i >> 2) + 4 * n + (i & 3); }

struct Unit { int pm, pn; };
struct Gemm { const bf16_t* A; const bf16_t* Bt; int M, N, K; };

struct StaticOrder {
    int nM, nN, nwg, G, c;
    __host__ __device__ void init(int M, int N, int G_, int c_) { nM = M / BM; nN = N / BM; nwg = nM * nN; G = G_; c = c_; }
    __host__ __device__ bool next(int i, Unit& u) const {
        const long L = (long)i * G + c; if (L >= nwg) return false;
        int wgid = (int)L; { const int q = nwg / NXCD, r = nwg % NXCD, xcd = wgid % NXCD, off = wgid / NXCD; wgid = (xcd < r ? xcd * (q + 1) : r * (q + 1) + (xcd - r) * q) + off; }
        const int nig = WGM * nN, gid = wgid / nig, fm = gid * WGM, gsz = (nM - fm) < WGM ? (nM - fm) : WGM;
        u.pm = fm + ((wgid % nig) % gsz); u.pn = (wgid % nig) / gsz; return true;
    }
    __device__ __forceinline__ void a_ready(const Unit&) const {}
    __device__ __forceinline__ void done(const Unit&) const {}
};

}
namespace pg8 {
__device__ __forceinline__ unsigned cvt_pk_bf16(float lo, float hi) { unsigned r; asm volatile("v_cvt_pk_bf16_f32 %0, %1, %2" : "=v"(r) : "v"(lo), "v"(hi)); return r; }
struct EpiQKV {
    static constexpr bool PERM = true, AFTER_DRAIN = false;
    bf16_t* O; size_t split_stride; float scale0;
    __device__ __forceinline__ void operator()(const f32x4 (&acc)[2][2][4][2], const Unit& u, int wr, int wc, int fr, int fq) const {
        const int row0 = u.pm * BM + wr * 64 + fr; const int t = u.pn >> 2; bf16_t* base = O + (size_t)t * split_stride; const float sc = (t == 0) ? scale0 : 1.f;
        const int col0 = (u.pn & 3) * BM + wc * 32 + 8 * fq;
#pragma unroll
        for (int ai = 0; ai < 2; ++ai)
#pragma unroll
            for (int m = 0; m < 4; ++m) { bf16_t* rowp = base + (size_t)(row0 + ai * HALF + m * 16) * 1024 + col0;
#pragma unroll
                for (int bj = 0; bj < 2; ++bj) { const f32x4 v0 = acc[ai][bj][m][0] * sc, v1 = acc[ai][bj][m][1] * sc;
                    u32x4 w; w.x = cvt_pk_bf16(v0[0], v0[1]); w.y = cvt_pk_bf16(v0[2], v0[3]); w.z = cvt_pk_bf16(v1[0], v1[1]); w.w = cvt_pk_bf16(v1[2], v1[3]);
                    *(u32x4*)(rowp + bj * HALF) = w; } }
    }
};
struct EpiRes {
    static constexpr bool PERM = false, AFTER_DRAIN = false;
    const float* base; float* out; const float* gate; int gate_bstride;
    __device__ __forceinline__ void operator()(const f32x4 (&acc)[2][2][4][2], const Unit& u, int wr, int wc, int fr, int fq) const {
        const int b = (u.pm * BM) >> 13; const float* gp = gate + (size_t)b * gate_bstride;
        const int col0 = u.pn * BM + wc * 32 + 4 * fq;
        f32x4 gv[2][2];
#pragma unroll
        for (int bj = 0; bj < 2; ++bj)
#pragma unroll
            for (int n = 0; n < 2; ++n) gv[bj][n] = *(const f32x4*)(gp + col0 + bj * HALF + n * 16);
        f32x4 bsA[2][2][2], bsB[2][2][2];
#define ER_LOAD(dst, k) do { _Pragma("unroll") for (int m2 = 0; m2 < 2; ++m2) { const size_t off_ = (size_t)(u.pm * BM + ((k) >> 1) * HALF + wr * 64 + (2 * ((k) & 1) + m2) * 16 + fr) * 1024 + col0; \
            _Pragma("unroll") for (int bj = 0; bj < 2; ++bj) _Pragma("unroll") for (int n = 0; n < 2; ++n) dst[m2][bj][n] = *(const f32x4*)(base + off_ + bj * HALF + n * 16); } } while (0)
#define ER_STORE(src, k) do { _Pragma("unroll") for (int m2 = 0; m2 < 2; ++m2) { const size_t off_ = (size_t)(u.pm * BM + ((k) >> 1) * HALF + wr * 64 + (2 * ((k) & 1) + m2) * 16 + fr) * 1024 + col0; \
            _Pragma("unroll") for (int bj = 0; bj < 2; ++bj) _Pragma("unroll") for (int n = 0; n < 2; ++n) *(f32x4*)(out + off_ + bj * HALF + n * 16) = src[m2][bj][n] + gv[bj][n] * acc[(k) >> 1][bj][2 * ((k) & 1) + m2][n]; } } while (0)
        ER_LOAD(bsA, 0); ER_LOAD(bsB, 1); asm volatile("" ::: "memory");
        ER_STORE(bsA, 0); ER_LOAD(bsA, 2); asm volatile("" ::: "memory");
        ER_STORE(bsB, 1); ER_LOAD(bsB, 3); asm volatile("" ::: "memory");
        ER_STORE(bsA, 2); ER_STORE(bsB, 3);
#undef ER_LOAD
#undef ER_STORE
    }
};
struct EpiResN {
    static constexpr bool PERM = false, AFTER_DRAIN = false;
    const float* base; float* out; const float* gate; int gate_bstride; bf16_t* A2; const float* ng; const float* nscale; float* part;
    __device__ __forceinline__ void operator()(const f32x4 (&acc)[2][2][4][2], const Unit& u, int wr, int wc, int fr, int fq) const {
        const int b = (u.pm * BM) >> 13; const float* gp = gate + (size_t)b * gate_bstride; const float* sp = nscale + (size_t)b * gate_bstride;
        const int col0 = u.pn * BM + wc * 32 + 4 * fq;
        f32x4 gv[2][2], av[2][2];
#pragma unroll
        for (int bj = 0; bj < 2; ++bj)
#pragma unroll
            for (int n = 0; n < 2; ++n) { const int c = col0 + bj * HALF + n * 16; gv[bj][n] = *(const f32x4*)(gp + c); av[bj][n] = *(const f32x4*)(ng + c) * (1.0f + *(const f32x4*)(sp + c)); }
#pragma unroll
        for (int ai = 0; ai < 2; ++ai) {
          for (int mh = 0; mh < 2; ++mh) {
            f32x4 bs[4][2][2];
#pragma unroll
            for (int m = 2 * mh; m < 2 * mh + 2; ++m) { const size_t off = (size_t)(u.pm * BM + ai * HALF + wr * 64 + m * 16 + fr) * 1024 + col0;
#pragma unroll
                for (int bj = 0; bj < 2; ++bj)
#pragma unroll
                    for (int n = 0; n < 2; ++n) bs[m][bj][n] = *(const f32x4*)(base + off + bj * HALF + n * 16); }
            asm volatile("" ::: "memory");
#pragma unroll
            for (int m = 2 * mh; m < 2 * mh + 2; ++m) { const int row = u.pm * BM + ai * HALF + wr * 64 + m * 16 + fr; const size_t off = (size_t)row * 1024 + col0; float ss = 0.f;
#pragma unroll
                for (int bj = 0; bj < 2; ++bj)
#pragma unroll
                    for (int n = 0; n < 2; ++n) { const f32x4 x1 = bs[m][bj][n] + gv[bj][n] * acc[ai][bj][m][n];
                        *(f32x4*)(out + off + bj * HALF + n * 16) = x1; ss += (x1[0] * x1[0] + x1[1] * x1[1]) + (x1[2] * x1[2] + x1[3] * x1[3]);
                        const f32x4 y = x1 * av[bj][n]; unsigned long long w = (unsigned long long)cvt_pk_bf16(y[0], y[1]) | ((unsigned long long)cvt_pk_bf16(y[2], y[3]) << 32);
                        *(unsigned long long*)(A2 + off + bj * HALF + n * 16) = w; }
                ss += __shfl_xor(ss, 16); ss += __shfl_xor(ss, 32);
                if (fq == 0) __hip_atomic_fetch_add(part + row, ss, __ATOMIC_RELAXED, __HIP_MEMORY_SCOPE_AGENT); }
          }
        }
    }
};
__device__ __forceinline__ void glds4(const void* gsrc, unsigned lds_dst) { unsigned keep;
  asm volatile("s_mov_b32 %0, m0\n\ts_mov_b32 m0, %2\n\ts_nop 0\n\tglobal_load_lds_dword %1, off\n\ts_mov_b32 m0, %0" : "=&s"(keep) : "v"(gsrc), "s"(lds_dst) : "memory"); }
struct SwiOrder {
    StaticOrder so; const float* part; const float* bias2; unsigned ldsx; mutable int k;
    __device__ bool next(int i, Unit& u) const { return so.next(i, u); }
    __device__ __forceinline__ void a_ready(const Unit& u) const {
        const int wid = __builtin_amdgcn_readfirstlane(threadIdx.x >> 6), lane = threadIdx.x & 63; const unsigned dst = ldsx + (unsigned)((k & 1) * 2048 + wid * 256); ++k;
        const float* src = (wid < 4) ? part + u.pm * BM + wid * 64 + lane : bias2 + (size_t)((u.pm * BM) >> 13) * 5632 + u.pn * BM + (wid - 4) * 64 + lane;
        glds4(src, (unsigned)__builtin_amdgcn_readfirstlane(dst));
    }
    __device__ __forceinline__ void done(const Unit&) const {}
};
struct EpiSwiGLU {
    static constexpr bool PERM = true, AFTER_DRAIN = false;
    bf16_t* O; unsigned ldsx; float eps; mutable int k;
    __device__ __forceinline__ void operator()(const f32x4 (&acc)[2][2][4][2], const Unit& u, int wr, int wc, int fr, int fq) const {
        const int row0 = u.pm * BM + wr * 64 + fr; const int col0 = u.pn * 128 + wc * 32 + 8 * fq;
        const PG8_LAS float* xs = (const PG8_LAS float*)(size_t)(ldsx + (unsigned)((k & 1) * 2048)); ++k;
        f32x4 bv[2][2]; float rs[2][4];
#pragma unroll
        for (int ai = 0; ai < 2; ++ai)
#pragma unroll
            for (int m = 0; m < 4; ++m) rs[ai][m] = xs[ai * HALF + wr * 64 + m * 16 + fr];
#pragma unroll
        for (int bj = 0; bj < 2; ++bj)
#pragma unroll
            for (int n = 0; n < 2; ++n) bv[bj][n] = *(const PG8_LAS f32x4*)(xs + 256 + bj * HALF + wc * 32 + 8 * fq + 4 * n);
#pragma unroll
        for (int ai = 0; ai < 2; ++ai)
#pragma unroll
            for (int m = 0; m < 4; ++m) { const int row = row0 + ai * HALF + m * 16;
                const float rstd = __builtin_amdgcn_rsqf(rs[ai][m] * (1.0f / 1024.0f) + eps);
                bf16_t* rowp = O + (size_t)row * 2816 + col0; float r[8];
#pragma unroll
                for (int n = 0; n < 2; ++n)
#pragma unroll
                    for (int e = 0; e < 4; ++e) { const float g = acc[ai][0][m][n][e] * rstd + bv[0][n][e], up = acc[ai][1][m][n][e] * rstd + bv[1][n][e];
                        const float sg = __builtin_amdgcn_rcpf(1.f + __builtin_amdgcn_exp2f(-1.4426950408889634f * g)); r[n * 4 + e] = g * sg * up; }
                u32x4 w; w.x = cvt_pk_bf16(r[0], r[1]); w.y = cvt_pk_bf16(r[2], r[3]); w.z = cvt_pk_bf16(r[4], r[5]); w.w = cvt_pk_bf16(r[6], r[7]);
                *(u32x4*)rowp = w; }
    }
};
struct EpiKVQ {
    static constexpr bool PERM = true, AFTER_DRAIN = false;
    bf16_t *Kb, *Vb, *Qb; const float *kg, *qg; float qscale, eps;
    __device__ __forceinline__ void operator()(const f32x4 (&acc)[2][2][4][2], const Unit& u, int wr, int wc, int fr, int fq) const {
        const int kind = u.pn >> 2; const int pm = (kind == 2) ? u.pm - 64 : u.pm; const int row0 = pm * BM + wr * 64 + fr;
        if (kind == 1) {
            const int col0 = (u.pn & 3) * BM + wc * 32 + 8 * fq;
#pragma unroll
            for (int ai = 0; ai < 2; ++ai)
#pragma unroll
                for (int m = 0; m < 4; ++m) { bf16_t* rowp = Vb + (size_t)(row0 + ai * HALF + m * 16) * 1024 + col0;
#pragma unroll
                    for (int bj = 0; bj < 2; ++bj) { const f32x4 v0 = acc[ai][bj][m][0], v1 = acc[ai][bj][m][1];
                        u32x4 w; w.x = cvt_pk_bf16(v0[0], v0[1]); w.y = cvt_pk_bf16(v0[2], v0[3]); w.z = cvt_pk_bf16(v1[0], v1[1]); w.w = cvt_pk_bf16(v1[2], v1[3]);
                        *(u32x4*)(rowp + bj * HALF) = w; } }
        } else {
            bf16_t* Ob = (kind == 0) ? Kb : Qb; const float* gsrc = (kind == 0) ? kg : qg; const float sc = (kind == 0) ? 1.f : qscale;
            f32x4 gv[2][2];
#pragma unroll
            for (int bj = 0; bj < 2; ++bj)
#pragma unroll
                for (int n = 0; n < 2; ++n) gv[bj][n] = *(const f32x4*)(gsrc + bj * 32 + 8 * fq + 4 * n) * sc;
            const int col0 = (u.pn & 3) * BM + wc * 64 + 8 * fq;
#pragma unroll
            for (int ai = 0; ai < 2; ++ai)
#pragma unroll
                for (int m = 0; m < 4; ++m) { float ss = 0.f;
#pragma unroll
                    for (int bj = 0; bj < 2; ++bj)
#pragma unroll
                        for (int n = 0; n < 2; ++n) { const f32x4 v = acc[ai][bj][m][n]; ss += (v[0] * v[0] + v[1] * v[1]) + (v[2] * v[2] + v[3] * v[3]); }
                    ss += __shfl_xor(ss, 16); ss += __shfl_xor(ss, 32);
                    const float rstd = 1.0f / sqrtf(ss * (1.0f / 64.0f) + eps);
                    bf16_t* rowp = Ob + (size_t)(row0 + ai * HALF + m * 16) * 1024 + col0;
#pragma unroll
                    for (int bj = 0; bj < 2; ++bj) { const f32x4 v0 = acc[ai][bj][m][0] * rstd * gv[bj][0], v1 = acc[ai][bj][m][1] * rstd * gv[bj][1];
                        u32x4 w; w.x = cvt_pk_bf16(v0[0], v0[1]); w.y = cvt_pk_bf16(v0[2], v0[3]); w.z = cvt_pk_bf16(v1[0], v1[1]); w.w = cvt_pk_bf16(v1[2], v1[3]);
                        *(u32x4*)(rowp + bj * 32) = w; } }
        }
    }
};
struct StackOrder {
    int G, c;
    __device__ bool next(int i, Unit& u) const {
        const int nwg = 768; const long L = (long)i * G + c; if (L >= nwg) return false;
        int wgid = (int)L; { const int q = nwg / NXCD, xcd = wgid % NXCD, off = wgid / NXCD; wgid = xcd * q + off; }
        if (wgid < 512) { const int nN = 8, nig = WGM * nN, gid = wgid / nig; u.pm = gid * WGM + ((wgid % nig) % WGM); u.pn = (wgid % nig) / WGM; }
        else { const int w2 = wgid - 512; const int nN = 4, nig = WGM * nN, gid = w2 / nig; u.pm = 64 + gid * WGM + ((w2 % nig) % WGM); u.pn = 8 + (w2 % nig) / WGM; }
        return true;
    }
    __device__ __forceinline__ void a_ready(const Unit&) const {}
    __device__ __forceinline__ void done(const Unit&) const {}
};
}
namespace pg8 {
template <class Epi, class Sched, bool ALIGN_EPI = false, bool SP2 = false>
__device__ __forceinline__ void gemm_phase(PG8_LAS unsigned char* lds, const Gemm g, const Sched& S, const Epi& E) {
    const int tid = threadIdx.x, wid = __builtin_amdgcn_readfirstlane(tid >> 6), lane = tid & 63, wr = wid >> 2, wc = wid & 3, fr = lane & 15, fq = lane >> 4;
    const int K = g.K, nt = K / BK;
    unsigned voffA[2], voffB[2];
#pragma unroll
    for (int i = 0; i < 2; ++i) { int R, C; stage_rc(tid * 16 + i * 8192, R, C); const int Rb = Epi::PERM ? ((R & ~31) + perm32(R & 31)) : R;
        voffA[i] = (unsigned)(R * K + C) * 2u; voffB[i] = (unsigned)(Rb * K + C) * 2u; }
    const size_t kstep = (size_t)(BK * 2);
    const size_t hstep = (size_t)HALF * K * 2;
    const size_t tstep = 2 * hstep;
    const unsigned ldsw = (unsigned)wid * 1024u;
    const int aoff = lds_byte(wr * 64 + fr, fq * 8), boff = lds_byte(wc * 32 + fr, fq * 8);
#define PG8_SA(b, h) (((b) * 2 + (h)) * HTB)
#define PG8_SB(b, h) ((4 + (b) * 2 + (h)) * HTB)
#define PG8_STAGE(bufoff, gbase, voff) do { _Pragma("unroll") for (int _i = 0; _i < 2; ++_i) \
        __builtin_amdgcn_global_load_lds((const unsigned*)((const char*)(gbase) + (voff)[_i]), (PG8_LAS unsigned*)(lds + (bufoff) + ldsw + _i * 8192), 16, 0, 0); } while (0)
#define PG8_LDA(dst, b, h) do { _Pragma("unroll") for (int m = 0; m < 4; ++m) _Pragma("unroll") for (int k = 0; k < 2; ++k) dst[m][k] = *(const PG8_LAS bf16x8*)(lds + PG8_SA(b, h) + aoff + m * 2048 + k * 1024); } while (0)
#define PG8_LDB(dst, b, h) do { _Pragma("unroll") for (int n = 0; n < 2; ++n) _Pragma("unroll") for (int k = 0; k < 2; ++k) dst[n][k] = *(const PG8_LAS bf16x8*)(lds + PG8_SB(b, h) + boff + n * 2048 + k * 1024); } while (0)
#define PG8_MMA(ai, bj, At, Bt) do { __builtin_amdgcn_s_setprio(1); _Pragma("unroll") for (int m = 0; m < 4; ++m) _Pragma("unroll") for (int n = 0; n < 2; ++n) _Pragma("unroll") for (int k = 0; k < 2; ++k) \
        acc[ai][bj][m][n] = __builtin_amdgcn_mfma_f32_16x16x32_bf16(Bt[n][k], At[m][k], acc[ai][bj][m][n], 0, 0, 0); __builtin_amdgcn_s_setprio(0); } while (0)
#define PG8_WAIT_V(n) asm volatile("s_waitcnt vmcnt(" #n ")" ::: "memory")
#define PG8_WAIT_L(n) asm volatile("s_waitcnt lgkmcnt(" #n ")" ::: "memory")
#define PG8_BAR __builtin_amdgcn_s_barrier()
#define PG8_SCHED __builtin_amdgcn_sched_barrier(0)
    Unit cur, nxt; int ui = 0;
    if (!S.next(0, cur)) return;
    f32x4 acc[2][2][4][2];
#pragma unroll
    for (int a = 0; a < 2; ++a)
#pragma unroll
        for (int b = 0; b < 2; ++b)
#pragma unroll
            for (int m = 0; m < 4; ++m)
#pragma unroll
                for (int n = 0; n < 2; ++n) acc[a][b][m][n] = (f32x4){0.f, 0.f, 0.f, 0.f};
    bf16x8 At[4][2], B0[2][2], B1[2][2];
    const char* cA = (const char*)g.A + (size_t)cur.pm * tstep; const char* cB = (const char*)g.Bt + (size_t)cur.pn * tstep;
    S.a_ready(cur);
    if constexpr (SP2) {
        PG8_STAGE(PG8_SB(0, 0), cB, voffB); PG8_STAGE(PG8_SB(0, 1), cB + hstep, voffB); PG8_STAGE(PG8_SA(0, 0), cA, voffA); PG8_STAGE(PG8_SA(0, 1), cA + hstep, voffA);
        if (wr == 1) PG8_BAR;
        PG8_WAIT_V(2); PG8_BAR;
        PG8_STAGE(PG8_SB(1, 0), cB + kstep, voffB); PG8_STAGE(PG8_SA(1, 0), cA + kstep, voffA); PG8_STAGE(PG8_SB(1, 1), cB + hstep + kstep, voffB);
        PG8_WAIT_V(6); PG8_BAR;
    } else {
        PG8_STAGE(PG8_SB(0, 0), cB, voffB); PG8_STAGE(PG8_SA(0, 0), cA, voffA); PG8_STAGE(PG8_SB(0, 1), cB + hstep, voffB); PG8_STAGE(PG8_SA(0, 1), cA + hstep, voffA);
        if (wr == 1) PG8_BAR;
        PG8_WAIT_V(4); PG8_BAR;
        PG8_STAGE(PG8_SB(1, 0), cB + kstep, voffB); PG8_STAGE(PG8_SA(1, 0), cA + kstep, voffA); PG8_STAGE(PG8_SB(1, 1), cB + hstep + kstep, voffB);
        PG8_WAIT_V(6); PG8_BAR;
    }
    for (;;) {
        const bool has_next = S.next(ui + 1, nxt);
        const char* nA = has_next ? (const char*)g.A + (size_t)nxt.pm * tstep : cA; const char* nB = has_next ? (const char*)g.Bt + (size_t)nxt.pn * tstep : cB;
        for (int t = 0; t < nt; t += 2) {
            const bool last = (t == nt - 2);
            const char* a1 = cA + (size_t)(t + 1) * kstep;
            const char* a2 = last ? nA : cA + (size_t)(t + 2) * kstep; const char* b2 = last ? nB : cB + (size_t)(t + 2) * kstep;
            const char* a3 = a2 + kstep; const char* b3 = b2 + kstep;
            if (last && has_next) S.a_ready(nxt);
            if constexpr (SP2) {
            PG8_LDB(B0, 0, 0); PG8_LDB(B1, 0, 1); PG8_SCHED; PG8_LDA(At, 0, 0); PG8_STAGE(PG8_SA(1, 1), a1 + hstep, voffA);
            PG8_WAIT_V(8); PG8_WAIT_L(0); PG8_BAR; PG8_MMA(0, 0, At, B0); PG8_MMA(0, 1, At, B1); PG8_BAR; PG8_SCHED;
            PG8_LDA(At, 0, 1); PG8_STAGE(PG8_SB(0, 0), b2, voffB); PG8_STAGE(PG8_SB(0, 1), b2 + hstep, voffB); PG8_STAGE(PG8_SA(0, 0), a2, voffA);
            PG8_WAIT_V(8); PG8_WAIT_L(0); PG8_BAR; PG8_MMA(1, 0, At, B0); PG8_MMA(1, 1, At, B1); PG8_BAR; PG8_SCHED;
            PG8_LDB(B0, 1, 0); PG8_LDB(B1, 1, 1); PG8_SCHED; PG8_LDA(At, 1, 0); PG8_STAGE(PG8_SA(0, 1), a2 + hstep, voffA);
            PG8_WAIT_V(8); PG8_WAIT_L(0); PG8_BAR; PG8_MMA(0, 0, At, B0); PG8_MMA(0, 1, At, B1); PG8_BAR; PG8_SCHED;
            PG8_LDA(At, 1, 1); PG8_STAGE(PG8_SB(1, 0), b3, voffB); PG8_STAGE(PG8_SB(1, 1), b3 + hstep, voffB); PG8_STAGE(PG8_SA(1, 0), a3, voffA);
            PG8_WAIT_V(8); PG8_WAIT_L(0); PG8_BAR; PG8_MMA(1, 0, At, B0); PG8_MMA(1, 1, At, B1); PG8_BAR; PG8_SCHED;
            } else {
            PG8_LDB(B0, 0, 0); PG8_SCHED; PG8_LDA(At, 0, 0); PG8_STAGE(PG8_SA(1, 1), a1 + hstep, voffA);
            PG8_WAIT_L(8); PG8_BAR; PG8_WAIT_L(0); PG8_MMA(0, 0, At, B0); PG8_BAR; PG8_SCHED;
            PG8_LDB(B1, 0, 1); PG8_STAGE(PG8_SB(0, 0), b2, voffB);
            PG8_BAR; PG8_WAIT_L(0); PG8_MMA(0, 1, At, B1); PG8_BAR;
            PG8_LDA(At, 0, 1); PG8_STAGE(PG8_SA(0, 0), a2, voffA);
            PG8_BAR; PG8_WAIT_L(0); PG8_MMA(1, 0, At, B0); PG8_BAR; PG8_SCHED;
            PG8_STAGE(PG8_SB(0, 1), b2 + hstep, voffB);
            PG8_WAIT_V(6); PG8_BAR; PG8_MMA(1, 1, At, B1); PG8_BAR;
            PG8_LDB(B0, 1, 0); PG8_SCHED; PG8_LDA(At, 1, 0); PG8_STAGE(PG8_SA(0, 1), a2 + hstep, voffA);
            PG8_WAIT_L(8); PG8_BAR; PG8_WAIT_L(0); PG8_MMA(0, 0, At, B0); PG8_BAR; PG8_SCHED;
            PG8_LDB(B1, 1, 1); PG8_STAGE(PG8_SB(1, 0), b3, voffB);
            PG8_BAR; PG8_WAIT_L(0); PG8_MMA(0, 1, At, B1); PG8_BAR;
            PG8_LDA(At, 1, 1); PG8_STAGE(PG8_SA(1, 0), a3, voffA);
            PG8_BAR; PG8_WAIT_L(0); PG8_MMA(1, 0, At, B0); PG8_BAR; PG8_SCHED;
            PG8_STAGE(PG8_SB(1, 1), b3 + hstep, voffB);
            PG8_WAIT_V(6); PG8_BAR; PG8_MMA(1, 1, At, B1); PG8_BAR;
            }
        }
        if constexpr (ALIGN_EPI) { if (wr == 0) PG8_BAR; }
        if constexpr (!Epi::AFTER_DRAIN) { E(acc, cur, wr, wc, fr, fq); S.done(cur); }
        if (!has_next) break;
#pragma unroll
        for (int a = 0; a < 2; ++a)
#pragma unroll
            for (int b = 0; b < 2; ++b)
#pragma unroll
                for (int m = 0; m < 4; ++m)
#pragma unroll
                    for (int n = 0; n < 2; ++n) acc[a][b][m][n] = (f32x4){0.f, 0.f, 0.f, 0.f};
        cur = nxt; cA = nA; cB = nB; ++ui;
        if constexpr (ALIGN_EPI) { if (wr == 1) PG8_BAR; }
    }
    PG8_WAIT_V(0);
    if constexpr (!ALIGN_EPI) { if (wr == 0) PG8_BAR; }
    PG8_BAR;
    if constexpr (Epi::AFTER_DRAIN) { E.fused(acc, cur, wr, wc, fr, fq, lds, wid, lane); S.done(cur); }
#undef PG8_SA
#undef PG8_SB
#undef PG8_STAGE
#undef PG8_LDA
#undef PG8_LDB
#undef PG8_MMA
#undef PG8_WAIT_V
#undef PG8_WAIT_L
#undef PG8_BAR
#undef PG8_SCHED
}
}
namespace att {
#define ALAS __attribute__((address_space(3)))
typedef unsigned short bf16_t;
using bf16x8 = __attribute__((ext_vector_type(8))) short;
using s16x4 = __attribute__((ext_vector_type(4))) short;
using f32x16 = __attribute__((ext_vector_type(16))) float;
using f32x4 = __attribute__((ext_vector_type(4))) float;
using u32x4 = __attribute__((ext_vector_type(4))) unsigned;
constexpr int SEQ = 8192, DM = 1024, NHEAD = 16, NW = 8, QBLK = 32, QB = 256, KVBLK = 64, NSLOT = 3, SLOTB = 8192;
constexpr int LDS_KV = 0, LDS_WS = 3 * 32768, LDS_OST = LDS_WS + NW * 64 * 4, LDS_FC = LDS_OST,
    LDS_FLG = LDS_FC + SEQ * 4, LDS_END = LDS_FLG + 128;
static_assert(LDS_END <= 147456 - 64, "attention LDS");
__device__ __forceinline__ int crow(int r, int hi) { return (r & 3) + 8 * (r >> 2) + 4 * hi; }
__device__ __forceinline__ void glds16(const void* gsrc, unsigned lds_dst) { unsigned keep;
  asm volatile("s_mov_b32 %0, m0\n\ts_mov_b32 m0, %2\n\ts_nop 0\n\tglobal_load_lds_dwordx4 %1, off\n\ts_mov_b32 m0, %0" : "=&s"(keep) : "v"(gsrc), "s"(lds_dst) : "memory"); }
typedef float f32x2_t __attribute__((ext_vector_type(2))); typedef __bf16 bf16x2_t __attribute__((ext_vector_type(2)));
__device__ __forceinline__ unsigned cvtpk_s(float lo, float hi) { f32x2_t v = {lo, hi}; bf16x2_t b = __builtin_convertvector(v, bf16x2_t); return __builtin_bit_cast(unsigned, b); }
#define AWAIT_BAR(N) asm volatile("s_waitcnt vmcnt(" #N ") lgkmcnt(0)\n\ts_barrier" ::: "memory")
typedef ALAS const char* lds_cptr;
__device__ __forceinline__ float xhalf(float v, int hi) { auto rr = __builtin_amdgcn_permlane32_swap(__float_as_uint(v), __float_as_uint(v), false, false); return __uint_as_float(hi ? rr[0] : rr[1]); }

__device__ __forceinline__ void qkt(f32x16& p0, f32x16& p1, unsigned kq, int so, const bf16x8* qr, const f32x16& cinit) {
#pragma unroll
  for (int d0 = 0; d0 < 4; ++d0) {
    const lds_cptr ka = (lds_cptr)(uintptr_t)((kq ^ (unsigned)(d0 << 5)) + (unsigned)so);
    const bf16x8 b0 = *(const ALAS bf16x8*)(ka);
    const bf16x8 b1 = *(const ALAS bf16x8*)(ka + 4096);
    if (d0 == 0) { p0 = __builtin_amdgcn_mfma_f32_32x32x16_bf16(b0, qr[0], cinit, 0, 0, 0); p1 = __builtin_amdgcn_mfma_f32_32x32x16_bf16(b1, qr[0], cinit, 0, 0, 0); }
    else { p0 = __builtin_amdgcn_mfma_f32_32x32x16_bf16(b0, qr[d0], p0, 0, 0, 0); p1 = __builtin_amdgcn_mfma_f32_32x32x16_bf16(b1, qr[d0], p1, 0, 0, 0); } }
}
constexpr float SKIP_L2 = 151.0f;
typedef short v4i16_t __attribute__((ext_vector_type(4)));
__device__ __forceinline__ s16x4 vtr(lds_cptr p) { return __builtin_bit_cast(s16x4, __builtin_amdgcn_ds_read_tr16_b64_v4i16((ALAS v4i16_t*)p)); }
__device__ __forceinline__ void pv2(f32x16* o, lds_cptr vp, const f32x16& p0, const f32x16& p1) {
  bf16x8 pa[4];
  { u32x4 w;
    w = (u32x4){cvtpk_s(p0[0], p0[1]), cvtpk_s(p0[2], p0[3]), cvtpk_s(p0[4], p0[5]), cvtpk_s(p0[6], p0[7])}; pa[0] = __builtin_bit_cast(bf16x8, w);
    w = (u32x4){cvtpk_s(p0[8], p0[9]), cvtpk_s(p0[10], p0[11]), cvtpk_s(p0[12], p0[13]), cvtpk_s(p0[14], p0[15])}; pa[1] = __builtin_bit_cast(bf16x8, w);
    w = (u32x4){cvtpk_s(p1[0], p1[1]), cvtpk_s(p1[2], p1[3]), cvtpk_s(p1[4], p1[5]), cvtpk_s(p1[6], p1[7])}; pa[2] = __builtin_bit_cast(bf16x8, w);
    w = (u32x4){cvtpk_s(p1[8], p1[9]), cvtpk_s(p1[10], p1[11]), cvtpk_s(p1[12], p1[13]), cvtpk_s(p1[14], p1[15])}; pa[3] = __builtin_bit_cast(bf16x8, w); }
#pragma unroll
  for (int ks = 0; ks < 4; ++ks)
#pragma unroll
    for (int d0 = 0; d0 < 2; ++d0) { const s16x4 lo = vtr(vp + d0 * 4096 + ks * 1024), hh = vtr(vp + d0 * 4096 + ks * 1024 + 512);
      const bf16x8 vf = (bf16x8){lo[0], lo[1], lo[2], lo[3], hh[0], hh[1], hh[2], hh[3]};
      o[d0] = __builtin_amdgcn_mfma_f32_32x32x16_bf16(pa[ks], vf, o[d0], 0, 0, 0); }
}
template <bool BAND> __device__ __forceinline__ void sb_tile(f32x16& p0, f32x16& p1, float& R, int krel0, int hi) {
  f32x16 s0, s1;
#pragma unroll
  for (int r = 0; r < 16; ++r) {
    const float z0 = p0[r], z1 = p1[r];
    const float u0 = __builtin_amdgcn_logf(1.0f + __builtin_amdgcn_exp2f(-__builtin_fabsf(z0))), u1 = __builtin_amdgcn_logf(1.0f + __builtin_amdgcn_exp2f(-__builtin_fabsf(z1)));
    s0[r] = __builtin_fmaf(0.5f, z0 + __builtin_fabsf(z0), u0); s1[r] = __builtin_fmaf(0.5f, z1 + __builtin_fabsf(z1), u1); }
  if (BAND) {
#pragma unroll
    for (int r = 0; r < 16; ++r) { const int kr = krel0 + (r & 3) + 8 * (r >> 2); if (kr >= 0) s0[r] = 0.f; if (kr + 32 >= 0) s1[r] = 0.f; } }
#pragma unroll
  for (int g = 0; g < 4; ++g) { s0[4 * g + 2] += s0[4 * g + 3]; s0[4 * g + 1] += s0[4 * g + 2]; s0[4 * g] += s0[4 * g + 1];
                                s1[4 * g + 2] += s1[4 * g + 3]; s1[4 * g + 1] += s1[4 * g + 2]; s1[4 * g] += s1[4 * g + 1]; }
  float W[9]; W[8] = 0.f;
#pragma unroll
  for (int g = 7; g >= 0; --g) W[g] = W[g + 1] + (g < 4 ? s0[4 * g] : s1[4 * (g - 4)]);
  float base[8]; float tot0 = 0.f; const float Rold = R;
#pragma unroll
  for (int g = 0; g < 8; ++g) { auto rr = __builtin_amdgcn_permlane32_swap(__float_as_uint(W[g]), __float_as_uint(W[g + 1]), false, false);
    const float wp = __uint_as_float(hi ? rr[0] : rr[1]); base[g] = Rold + W[g + 1] + wp; if (g == 0) tot0 = W[0] + wp; }
  { const float pt = xhalf(tot0, hi); R = Rold + (hi ? pt : tot0); }
#pragma unroll
  for (int r = 0; r < 16; ++r) { p0[r] = __builtin_amdgcn_exp2f(p0[r] - (base[r >> 2] + s0[r])); p1[r] = __builtin_amdgcn_exp2f(p1[r] - (base[4 + (r >> 2)] + s1[r])); }
  if (BAND) {
#pragma unroll
    for (int r = 0; r < 16; ++r) { const int kr = krel0 + (r & 3) + 8 * (r >> 2); if (kr >= 0) p0[r] = 0.f; if (kr + 32 >= 0) p1[r] = 0.f; } }
}
template <bool BAND, bool WANT_MAX> __device__ __forceinline__ float fox_logits(f32x16& p0, f32x16& p1, const ALAS float* fc, int krel0, float c) {
#pragma unroll
  for (int g = 0; g < 4; ++g) { const f32x4 f0 = *(const ALAS f32x4*)(fc + 8 * g), f1 = *(const ALAS f32x4*)(fc + 32 + 8 * g);
#pragma unroll
    for (int e = 0; e < 4; ++e) { p0[4 * g + e] += f0[e] + c; p1[4 * g + e] += f1[e] + c; } }
  if (BAND) {
#pragma unroll
    for (int r = 0; r < 16; ++r) { const int kr = krel0 + (r & 3) + 8 * (r >> 2); if (kr > 0) p0[r] = -INFINITY; if (kr + 32 > 0) p1[r] = -INFINITY; } }
  float a = 0.f;
  if (WANT_MAX) { a = __builtin_fmaxf(p0[0], p1[0]);
#pragma unroll
    for (int r = 1; r < 16; ++r) a = __builtin_fmaxf(a, __builtin_fmaxf(p0[r], p1[r])); }
  return a;
}
__device__ __forceinline__ void kread8(bf16x8* kf, unsigned kq, int so) {
#pragma unroll
  for (int d0 = 0; d0 < 4; ++d0) { const lds_cptr ka = (lds_cptr)(uintptr_t)((kq ^ (unsigned)(d0 << 5)) + (unsigned)so); kf[2 * d0] = *(const ALAS bf16x8*)(ka); kf[2 * d0 + 1] = *(const ALAS bf16x8*)(ka + 4096); }
}
__device__ __forceinline__ void kread4(bf16x8* kf, unsigned kq, int so, int half) {
#pragma unroll
  for (int d = 0; d < 2; ++d) { const int d0 = 2 * half + d; const lds_cptr ka = (lds_cptr)(uintptr_t)((kq ^ (unsigned)(d0 << 5)) + (unsigned)so); kf[2 * d0] = *(const ALAS bf16x8*)(ka); kf[2 * d0 + 1] = *(const ALAS bf16x8*)(ka + 4096); }
}
__device__ __forceinline__ void qk8(f32x16& p0, f32x16& p1, const bf16x8* kf, const bf16x8* qr, const f32x16& cinit) {
  p0 = __builtin_amdgcn_mfma_f32_32x32x16_bf16(kf[0], qr[0], cinit, 0, 0, 0); p1 = __builtin_amdgcn_mfma_f32_32x32x16_bf16(kf[1], qr[0], cinit, 0, 0, 0);
#pragma unroll
  for (int d0 = 1; d0 < 4; ++d0) { p0 = __builtin_amdgcn_mfma_f32_32x32x16_bf16(kf[2 * d0], qr[d0], p0, 0, 0, 0); p1 = __builtin_amdgcn_mfma_f32_32x32x16_bf16(kf[2 * d0 + 1], qr[d0], p1, 0, 0, 0); }
}
__device__ __forceinline__ void vread16(bf16x8* vf, lds_cptr vp) {
#pragma unroll
  for (int ks = 0; ks < 4; ++ks)
#pragma unroll
    for (int d0 = 0; d0 < 2; ++d0) { const s16x4 lo = vtr(vp + d0 * 4096 + ks * 1024), hh = vtr(vp + d0 * 4096 + ks * 1024 + 512);
      vf[2 * ks + d0] = (bf16x8){lo[0], lo[1], lo[2], lo[3], hh[0], hh[1], hh[2], hh[3]}; }
}
__device__ __forceinline__ void vread8(bf16x8* vf, lds_cptr vp, int half) {
#pragma unroll
  for (int k2 = 0; k2 < 2; ++k2)
#pragma unroll
    for (int d0 = 0; d0 < 2; ++d0) { const int ks = 2 * half + k2; const s16x4 lo = vtr(vp + d0 * 4096 + ks * 1024), hh = vtr(vp + d0 * 4096 + ks * 1024 + 512);
      vf[2 * ks + d0] = (bf16x8){lo[0], lo[1], lo[2], lo[3], hh[0], hh[1], hh[2], hh[3]}; }
}
__device__ __forceinline__ void pack4(bf16x8* pa, const f32x16& p0, const f32x16& p1) {
  u32x4 w;
  w = (u32x4){cvtpk_s(p0[0], p0[1]), cvtpk_s(p0[2], p0[3]), cvtpk_s(p0[4], p0[5]), cvtpk_s(p0[6], p0[7])}; pa[0] = __builtin_bit_cast(bf16x8, w);
  w = (u32x4){cvtpk_s(p0[8], p0[9]), cvtpk_s(p0[10], p0[11]), cvtpk_s(p0[12], p0[13]), cvtpk_s(p0[14], p0[15])}; pa[1] = __builtin_bit_cast(bf16x8, w);
  w = (u32x4){cvtpk_s(p1[0], p1[1]), cvtpk_s(p1[2], p1[3]), cvtpk_s(p1[4], p1[5]), cvtpk_s(p1[6], p1[7])}; pa[2] = __builtin_bit_cast(bf16x8, w);
  w = (u32x4){cvtpk_s(p1[8], p1[9]), cvtpk_s(p1[10], p1[11]), cvtpk_s(p1[12], p1[13]), cvtpk_s(p1[14], p1[15])}; pa[3] = __builtin_bit_cast(bf16x8, w);
}
__device__ __forceinline__ void pv8(f32x16* o, const bf16x8* pa, const bf16x8* vf) {
#pragma unroll
  for (int ks = 0; ks < 4; ++ks)
#pragma unroll
    for (int d0 = 0; d0 < 2; ++d0) o[d0] = __builtin_amdgcn_mfma_f32_32x32x16_bf16(pa[ks], vf[2 * ks + d0], o[d0], 0, 0, 0);
}
__device__ __forceinline__ void fox_init(f32x16& p0, f32x16& p1, const ALAS float* fc, float c) {
#pragma unroll
  for (int g = 0; g < 4; ++g) { const f32x4 f0 = *(const ALAS f32x4*)(fc + 8 * g), f1 = *(const ALAS f32x4*)(fc + 32 + 8 * g);
#pragma unroll
    for (int e = 0; e < 4; ++e) { p0[4 * g + e] = c + f0[e]; p1[4 * g + e] = c + f1[e]; } }
}
__device__ __forceinline__ void fox_init0(f32x16& p0, f32x16& p1, const ALAS float* fc) {
#pragma unroll
  for (int g = 0; g < 4; ++g) { const f32x4 f0 = *(const ALAS f32x4*)(fc + 8 * g), f1 = *(const ALAS f32x4*)(fc + 32 + 8 * g);
#pragma unroll
    for (int e = 0; e < 4; ++e) { p0[4 * g + e] = f0[e]; p1[4 * g + e] = f1[e]; } }
}
__device__ __forceinline__ void qk8acc(f32x16& p0, f32x16& p1, const bf16x8* kf, const bf16x8* qr) {
#pragma unroll
  for (int d0 = 0; d0 < 4; ++d0) { p0 = __builtin_amdgcn_mfma_f32_32x32x16_bf16(kf[2 * d0], qr[d0], p0, 0, 0, 0); p1 = __builtin_amdgcn_mfma_f32_32x32x16_bf16(kf[2 * d0 + 1], qr[d0], p1, 0, 0, 0); }
}
#define SBAR0() __builtin_amdgcn_sched_barrier(0)
#define SGB_PATTERN(NM, ND, NV) do { _Pragma("unroll") for (int g_ = 0; g_ < (NM); ++g_) { __builtin_amdgcn_sched_group_barrier(0x008, 1, 0); if ((ND) > 0) __builtin_amdgcn_sched_group_barrier(0x100, (ND), 0); if ((NV) > 0) __builtin_amdgcn_sched_group_barrier(0x002, (NV), 0); } } while (0)
template <int MODE> __device__ __forceinline__ void attn_unit(int b, int h, int qb, const bf16_t* Q, const bf16_t* __restrict__ K, const bf16_t* __restrict__ V, bf16_t* O, const float* FC2, const float* kgain, ALAS char* shm) {
  int tid = threadIdx.x; asm volatile("" : "+v"(tid));
  const int lane = tid & 63, r32 = lane & 31, hi = lane >> 5; const int wid = __builtin_amdgcn_readfirstlane(tid >> 6);
  const long rowbase = (long)b * SEQ; const int q0 = qb * QB;
  const bf16_t* Qw = Q + (rowbase + q0 + wid * QBLK) * DM + h * 64;
  const bf16_t *Kh = K + rowbase * DM + h * 64, *Vh = V + rowbase * DM + h * 64;
  const unsigned lds0 = (unsigned)(uintptr_t)shm;
  ALAS float* wsf = (ALAS float*)(shm + LDS_WS) + wid * 64;
  const bf16_t* ksrc = Kh + (long)(8 * wid + (lane >> 3)) * DM + (((lane & 7) ^ ((lane >> 3) & 7)) * 8);
  const bf16_t* vsrc = Vh + (long)(16 * (wid & 3) + (lane >> 2)) * DM + (wid >> 2) * 32 + (lane & 3) * 8;
  const unsigned pdst = lds0 + LDS_KV + wid * 1024;
#define DMA_PAIR(tA, sb) do { glds16(ksrc + (long)(tA) * KVBLK * DM, (unsigned)__builtin_amdgcn_readfirstlane(pdst + (sb))); glds16(ksrc + (long)((tA) - 1) * KVBLK * DM, (unsigned)__builtin_amdgcn_readfirstlane(pdst + (sb) + 8192)); \
    glds16(vsrc + (long)(tA) * KVBLK * DM, (unsigned)__builtin_amdgcn_readfirstlane(pdst + (sb) + 16384)); glds16(vsrc + (long)((tA) - 1) * KVBLK * DM, (unsigned)__builtin_amdgcn_readfirstlane(pdst + (sb) + 24576)); } while (0)
  const unsigned kq = (unsigned)(uintptr_t)((lds_cptr)shm + LDS_KV) + r32 * 128 + ((hi ^ (r32 & 7)) << 4);
  const lds_cptr vp0 = (lds_cptr)shm + LDS_KV + 16384 + ((lane >> 4) & 1) * 32 + (lane & 3) * 8 + (4 * hi + ((lane & 15) >> 2)) * 64;
  const int NT = (q0 + QB) / KVBLK, NS = NT / 2;
  DMA_PAIR(NT - 1, 0); DMA_PAIR(NT - 3, 32768);
  bf16x8 qr[4];
#pragma unroll
  for (int d0 = 0; d0 < 4; ++d0) qr[d0] = *reinterpret_cast<const bf16x8*>(&Qw[(long)r32 * DM + d0 * 16 + hi * 8]);
  const int qrel = wid * QBLK + r32;
  float fq2 = 0.f; bool fast = false;
  if (MODE == 1) {
    const float* fsrc = FC2 + ((long)b * NHEAD + h) * SEQ; ALAS float* fc = (ALAS float*)(shm + LDS_FC);
    f32x4 fv[4];
#pragma unroll
    for (int j = 0; j < 4; ++j) { const int i = tid * 4 + j * 2048; if (i < q0 + QB) fv[j] = *(const f32x4*)(fsrc + i); }
    const float fref = fsrc[q0 + 128];
#pragma unroll
    for (int j = 0; j < 4; ++j) { const int i = tid * 4 + j * 2048; if (i < q0 + QB) *(ALAS f32x4*)(fc + i) = fref - fv[j]; }
    fq2 = fsrc[q0 + qrel] - fref;
    fast = __builtin_amdgcn_readfirstlane((fsrc[q0] - fsrc[q0 + QB - 1]) <= 50.0f ? 1 : 0) != 0;
  }
  f32x16 o[2]; o[0] = f32x16{}; o[1] = f32x16{};
  float R = 0.f;
  float mhat = 0.f;
  float zb = 0.f;
  if (MODE == 1) {
    float ss = 0.f;
#pragma unroll
    for (int d0 = 0; d0 < 4; ++d0)
#pragma unroll
      for (int e = 0; e < 8; ++e) { const float qv = __uint_as_float(((unsigned)(unsigned short)qr[d0][e]) << 16); ss += qv * qv; }
    ss += xhalf(ss, hi);
    float gm = __builtin_fabsf(kgain[lane]);
#pragma unroll
    for (int o_ = 1; o_ < 64; o_ <<= 1) gm = __builtin_fmaxf(gm, __shfl_xor(gm, o_));
    zb = sqrtf(ss) * gm * 8.0f * 1.01f;
  }
  ALAS unsigned* flg = (ALAS unsigned*)(shm + LDS_FLG);
  const int i_first = (wid < 4) ? 1 : 0;
  const f32x16 zc = f32x16{};
#define STEP_BODY(BANDV) do { \
      const int tA = NT - 1 - 2 * si; const int krA = tA * KVBLK - q0 + 4 * hi - qrel, krB = krA - KVBLK; \
      const lds_cptr vpA = vp0 + sbl, vpB = vp0 + sbl + 8192; \
      f32x16 pA0, pA1, pB0, pB1; \
      const bool skipA = (MODE == 0) && BANDV && (tA * KVBLK - q0 >= 32 * wid + 31);     \
      if (MODE == 0) { \
        if (!skipA) qkt(pA0, pA1, kq, sbl, qr, zc); \
        qkt(pB0, pB1, kq, sbl + 8192, qr, zc); \
        if (!skipA) sb_tile<BANDV>(pA0, pA1, R, krA, hi); \
        sb_tile<BANDV>(pB0, pB1, R, krB, hi); \
      } else { \
        const float c_ = fast ? 0.f : (si == i_first ? fq2 : fq2 - mhat); const f32x16 z0_ = f32x16{}; \
        qkt(pA0, pA1, kq, sbl, qr, z0_); qkt(pB0, pB1, kq, sbl + 8192, qr, z0_); \
        const ALAS float* fc = (const ALAS float*)(shm + LDS_FC) + tA * KVBLK + 4 * hi; \
        if (BANDV && si == i_first) {         \
          float rm = __builtin_fmaxf(fox_logits<true, true>(pA0, pA1, fc, krA, c_), fox_logits<true, true>(pB0, pB1, fc - KVBLK, krB, c_)); \
          rm = __builtin_fmaxf(rm, xhalf(rm, hi)); mhat = rm; const float sub_ = fast ? 0.f : rm; \
          _Pragma("unroll") for (int r = 0; r < 16; ++r) { pA0[r] -= sub_; pA1[r] -= sub_; pB0[r] -= sub_; pB1[r] -= sub_; } \
        } else { (void)fox_logits<BANDV, false>(pA0, pA1, fc, krA, c_); (void)fox_logits<BANDV, false>(pB0, pB1, fc - KVBLK, krB, c_); } \
        float sacc = 0.f; \
        _Pragma("unroll") for (int r = 0; r < 16; ++r) { pA0[r] = __builtin_amdgcn_exp2f(pA0[r]); pA1[r] = __builtin_amdgcn_exp2f(pA1[r]); pB0[r] = __builtin_amdgcn_exp2f(pB0[r]); pB1[r] = __builtin_amdgcn_exp2f(pB1[r]); \
          sacc += (pA0[r] + pA1[r]) + (pB0[r] + pB1[r]); } \
        R += sacc; \
      } \
      if (!skipA) pv2(o, vpA, pA0, pA1); \
      pv2(o, vpB, pB0, pB1); \
    } while (0)
#define STEP_PIPE(FASTV) do { \
      const int tA = NT - 1 - 2 * si; \
      const lds_cptr vpA = vp0 + sbl, vpB = vp0 + sbl + 8192; \
      f32x16 pA0, pA1, pB0, pB1; bf16x8 kfa[8], kfb[8], vfa[8], vfb[8], paA[4], paB[4]; \
      if (MODE == 0) { \
        SBAR0(); kread8(kfa, kq, sbl); SBAR0(); \
        qk8(pA0, pA1, kfa, qr, zc); kread8(kfb, kq, sbl + 8192); SGB_PATTERN(8, 1, 0); SBAR0(); \
        qk8(pB0, pB1, kfb, qr, zc); sb_tile<false>(pA0, pA1, R, 0, hi); pack4(paA, pA0, pA1); SGB_PATTERN(8, 0, 58); SBAR0(); \
        vread16(vfa, vpA); __builtin_amdgcn_sched_group_barrier(0x100, 16, 0); \
        pv8(o, paA, vfa); sb_tile<false>(pB0, pB1, R, 0, hi); pack4(paB, pB0, pB1); SGB_PATTERN(8, 0, 58); SBAR0(); \
        vread16(vfb, vpB); pv8(o, paB, vfb); SBAR0(); \
      } else { \
        const ALAS float* fc = (const ALAS float*)(shm + LDS_FC) + tA * KVBLK + 4 * hi; const float c = fq2 - mhat; \
        SBAR0(); kread8(kfa, kq, sbl); if (FASTV) fox_init0(pA0, pA1, fc); else fox_init(pA0, pA1, fc, c); SBAR0(); \
        qk8acc(pA0, pA1, kfa, qr); if (!FASTV) { fox_init(pB0, pB1, fc - KVBLK, c); SGB_PATTERN(8, 1, 8); } SBAR0(); \
        kread8(kfb, kq, sbl + 8192); if (FASTV) fox_init0(pB0, pB1, fc - KVBLK); qk8acc(pB0, pB1, kfb, qr); { float sa = 0.f; \
          _Pragma("unroll") for (int r = 0; r < 16; ++r) { pA0[r] = __builtin_amdgcn_exp2f(pA0[r]); pA1[r] = __builtin_amdgcn_exp2f(pA1[r]); sa += pA0[r] + pA1[r]; } R += sa; } \
        pack4(paA, pA0, pA1); SGB_PATTERN(8, 0, 11); SBAR0(); \
        vread16(vfa, vpA); __builtin_amdgcn_sched_group_barrier(0x100, 16, 0); pv8(o, paA, vfa); { float sa = 0.f; \
          _Pragma("unroll") for (int r = 0; r < 16; ++r) { pB0[r] = __builtin_amdgcn_exp2f(pB0[r]); pB1[r] = __builtin_amdgcn_exp2f(pB1[r]); sa += pB0[r] + pB1[r]; } R += sa; } \
        pack4(paB, pB0, pB1); SGB_PATTERN(8, 0, 11); SBAR0(); \
        vread16(vfb, vpB); pv8(o, paB, vfb); SBAR0(); \
      } \
    } while (0)
  int sb = 0, sb2 = 65536; bool wdone = false;
  const int lead = (wid < 4) ? 1 : 0;
  if (wid >= 4) __builtin_amdgcn_s_setprio(2);
  for (int i = 0; i < NS; ++i) {
    AWAIT_BAR(0);
    if (i > 0) {
      const u32x4 fa = *(const ALAS u32x4*)(flg + 8 * ((i - 1) & 1)), fb = *(const ALAS u32x4*)(flg + 8 * ((i - 1) & 1) + 4);
      if (((fa.x & fa.y) & (fa.z & fa.w) & (fb.x & fb.y) & (fb.z & fb.w)) != 0u) break;
    }
    if (i + 2 < NS) DMA_PAIR(NT - 5 - 2 * i, sb2);
    const int si = i + lead; const int sbl = lead ? ((sb == 65536) ? 0 : sb + 32768) : sb;
    if (si < NS && !wdone) { if (si < 2) STEP_BODY(true); else if (MODE == 1 && fast) STEP_PIPE(true); else if (MODE == 1) STEP_BODY(false); else STEP_PIPE(false);     }
    { bool done_ = wdone || (si + 1 >= NS);
      if (!done_) {
        if (MODE == 0) done_ = __all(R > SKIP_L2);
        else { const float fe = *((const ALAS float*)(shm + LDS_FC) + (NT - 2 - 2 * si) * KVBLK - 1);
               done_ = __all(zb + fe + (fast ? 0.f : fq2) - mhat < -SKIP_L2); } }
      wdone = done_;
      if (lane == 0) flg[8 * (i & 1) + wid] = done_ ? 1u : 0u; }
    sb = (sb == 65536) ? 0 : sb + 32768; sb2 = (sb2 == 65536) ? 0 : sb2 + 32768;
  }
#undef STEP_BODY
#undef STEP_PIPE
  __builtin_amdgcn_s_setprio(0);
  AWAIT_BAR(0);
  int tid2 = tid; asm volatile("" : "+v"(tid2));
  const int lane2 = tid2 & 63, r32b = lane2 & 31, hib = lane2 >> 5;
  ALAS float* wsf2 = (ALAS float*)(shm + LDS_WS) + wid * 64;
  float rli[16];
  if (MODE == 1) {
    const float l = R + xhalf(R, hib);
    if (hib == 0) wsf2[32 + r32b] = l;
#pragma unroll
    for (int r = 0; r < 16; ++r) rli[r] = __builtin_amdgcn_rcpf(wsf2[32 + crow(r, hib)]);
  } else {
#pragma unroll
    for (int r = 0; r < 16; ++r) rli[r] = 1.f;
  }
  bf16_t* Ow = O + (rowbase + q0 + wid * QBLK) * DM + h * 64;
  { ALAS bf16_t* stg = (ALAS bf16_t*)(shm + LDS_OST) + wid * 2048;
#pragma unroll
    for (int r = 0; r < 16; ++r) { const int orow = crow(r, hib);
#pragma unroll
      for (int d0 = 0; d0 < 2; ++d0) { const unsigned pk = cvtpk_s(o[d0][r] * rli[r], 0.f); stg[orow * 64 + d0 * 32 + r32b] = (bf16_t)(pk & 0xffffu); } }
    asm volatile("s_waitcnt lgkmcnt(0)" ::: "memory");
#pragma unroll
    for (int i = 0; i < 4; ++i) { const int row = i * 8 + (lane2 >> 3), ch = lane2 & 7; const u32x4 v = *(const ALAS u32x4*)(stg + row * 64 + ch * 8); *(u32x4*)(Ow + (long)row * DM + ch * 8) = v; } }
  asm volatile("s_waitcnt lgkmcnt(0)\n\ts_barrier" ::: "memory");
#undef DMA_PAIR
}
template <int MODE> __device__ __forceinline__ void attn_phase(ALAS char* lds, const bf16_t* Q, const bf16_t* K, const bf16_t* V, bf16_t* O, const float* FC2, const float* kgain, unsigned* ctr) {
  ALAS unsigned* qw = (ALAS unsigned*)(lds + LDS_FLG) + 16;
  for (;;) {
    if (threadIdx.x == 0) *qw = __hip_atomic_fetch_add(ctr, 1u, __ATOMIC_RELAXED, __HIP_MEMORY_SCOPE_AGENT);
    __syncthreads();
    const unsigned u = *qw;
    if (u >= 1024u) break;
    const int qb = 31 - (int)(u >> 5), bh = (int)(u & 31u);
    attn_unit<MODE>(bh / NHEAD, bh % NHEAD, qb, Q, K, V, O, FC2, kgain, lds);
  }
}
template <bool BAND> __device__ __forceinline__ void sb_half(f32x16& p, float& R, int krel0, int hi) {
  f32x16 s;
#pragma unroll
  for (int r = 0; r < 16; ++r) { const float z = p[r]; const float u = __builtin_amdgcn_logf(1.0f + __builtin_amdgcn_exp2f(-__builtin_fabsf(z))); s[r] = __builtin_fmaf(0.5f, z + __builtin_fabsf(z), u); }
  if (BAND) {
#pragma unroll
    for (int r = 0; r < 16; ++r) { const int kr = krel0 + (r & 3) + 8 * (r >> 2); if (kr >= 0) s[r] = 0.f; } }
#pragma unroll
  for (int g = 0; g < 4; ++g) { s[4 * g + 2] += s[4 * g + 3]; s[4 * g + 1] += s[4 * g + 2]; s[4 * g] += s[4 * g + 1]; }
  float W[5]; W[4] = 0.f;
#pragma unroll
  for (int g = 3; g >= 0; --g) W[g] = W[g + 1] + s[4 * g];
  float base[4]; float tot0 = 0.f; const float Rold = R;
#pragma unroll
  for (int g = 0; g < 4; ++g) { auto rr = __builtin_amdgcn_permlane32_swap(__float_as_uint(W[g]), __float_as_uint(W[g + 1]), false, false);
    const float wp = __uint_as_float(hi ? rr[0] : rr[1]); base[g] = Rold + W[g + 1] + wp; if (g == 0) tot0 = W[0] + wp; }
  { const float pt = xhalf(tot0, hi); R = Rold + (hi ? pt : tot0); }
#pragma unroll
  for (int r = 0; r < 16; ++r) p[r] = __builtin_amdgcn_exp2f(p[r] - (base[r >> 2] + s[r]));
  if (BAND) {
#pragma unroll
    for (int r = 0; r < 16; ++r) { const int kr = krel0 + (r & 3) + 8 * (r >> 2); if (kr >= 0) p[r] = 0.f; } }
}
__device__ __forceinline__ void sb_wave_unit(int b, int h, int rb, const bf16_t* Q, const bf16_t* __restrict__ K, const bf16_t* __restrict__ V, bf16_t* O, ALAS char* wl) {
  int tid = threadIdx.x; asm volatile("" : "+v"(tid));
  const int lane = tid & 63, r32 = lane & 31, hi = lane >> 5;
  const long rowbase = (long)b * SEQ; const int r0 = rb * QBLK;
  const bf16_t* Qw = Q + (rowbase + r0) * DM + h * 64;
  const bf16_t *Kh = K + rowbase * DM + h * 64, *Vh = V + rowbase * DM + h * 64;
  const unsigned l0 = (unsigned)(uintptr_t)wl;
  const bf16_t* ksrc = Kh + (long)(lane >> 3) * DM + (((lane & 7) ^ ((lane >> 3) & 7)) * 8);
  const bf16_t* vsrc = Vh + (long)(lane >> 2) * DM + (lane & 3) * 8;
  const unsigned kq = l0 + r32 * 128 + ((hi ^ (r32 & 7)) << 4);
  const lds_cptr vp = (lds_cptr)wl + 8192 + ((lane >> 4) & 1) * 32 + (lane & 3) * 8 + (4 * hi + ((lane & 15) >> 2)) * 64;
  bf16x8 qr[4];
#pragma unroll
  for (int d0 = 0; d0 < 4; ++d0) qr[d0] = *reinterpret_cast<const bf16x8*>(&Qw[(long)r32 * DM + d0 * 16 + hi * 8]);
  f32x16 o[2]; o[0] = f32x16{}; o[1] = f32x16{}; float R = 0.f; const f32x16 zc = f32x16{};
  const int tdiag = (r0 + QBLK - 1) >> 6;
  for (int t = tdiag; t >= 0; --t) {
#pragma unroll
    for (int j = 0; j < 8; ++j) glds16(ksrc + (long)(64 * t + 8 * j) * DM, (unsigned)__builtin_amdgcn_readfirstlane(l0 + j * 1024));
#pragma unroll
    for (int p = 0; p < 8; ++p) glds16(vsrc + (long)(64 * t + 16 * (p & 3)) * DM + 32 * (p >> 2), (unsigned)__builtin_amdgcn_readfirstlane(l0 + 8192 + p * 1024));
    asm volatile("s_waitcnt vmcnt(0)" ::: "memory");
    f32x16 p0, p1; bf16x8 kf[8], vf[8], pa[4];
    kread8(kf, kq, 0); SBAR0(); qk8(p0, p1, kf, qr, zc);
    vread16(vf, vp); SBAR0();
    bool stop = false;
    if (t == tdiag) {
      if ((r0 & 32) == 0) { p1 = f32x16{}; sb_half<true>(p0, R, 64 * t - r0 + 4 * hi - r32, hi); }
      else { sb_half<true>(p1, R, 64 * t + 32 - r0 + 4 * hi - r32, hi); sb_half<false>(p0, R, 0, hi); }
    } else {
      sb_half<false>(p1, R, 0, hi);
      if (__all(R > SKIP_L2)) { p0 = f32x16{}; stop = true; } else sb_half<false>(p0, R, 0, hi);
    }
    pack4(pa, p0, p1); pv8(o, pa, vf);
    asm volatile("s_waitcnt lgkmcnt(0)" ::: "memory");
    if (stop || __all(R > SKIP_L2)) break;
  }
  { ALAS bf16_t* stg = (ALAS bf16_t*)wl;
#pragma unroll
    for (int r = 0; r < 16; ++r) { const int orow = crow(r, hi);
#pragma unroll
      for (int d0 = 0; d0 < 2; ++d0) { const unsigned pk = cvtpk_s(o[d0][r], 0.f); stg[orow * 64 + d0 * 32 + r32] = (bf16_t)(pk & 0xffffu); } }
    asm volatile("s_waitcnt lgkmcnt(0)" ::: "memory");
    bf16_t* Ow = O + (rowbase + r0) * DM + h * 64;
#pragma unroll
    for (int i = 0; i < 4; ++i) { const int row = i * 8 + (lane >> 3), ch = lane & 7; const u32x4 v = *(const ALAS u32x4*)(stg + row * 64 + ch * 8); *(u32x4*)(Ow + (long)row * DM + ch * 8) = v; }
    asm volatile("s_waitcnt lgkmcnt(0)" ::: "memory"); }
}
__device__ __forceinline__ void sb_wave_phase(ALAS char* lds, const bf16_t* Q, const bf16_t* K, const bf16_t* V, bf16_t* O, int G, int bx) {
  const int wid = __builtin_amdgcn_readfirstlane(threadIdx.x >> 6); ALAS char* wl = lds + wid * 16384;
  const int NWV = G * NW;
  for (int wu = bx * NW + wid; wu < 32 * 256 * 4 / 4 * 4 / 4; wu += NWV) {
    const int g = wu % 2048, j = wu / 2048; const int bh = (g >> 8) + 8 * j, rb = g & 255;
    sb_wave_unit(bh / NHEAD, bh % NHEAD, rb, Q, K, V, O, wl);
  }
}
}
constexpr int NWAVES = 8;
constexpr int BATCH = 2, T = 8192, D = 1024, H = 16, HD = 64, FF = 2816, M = BATCH * T;
constexpr float RMS_EPS = 1e-6f;
constexpr float LOG2E = 1.4426950408889634f;
constexpr float QSCALE = 0.125f * LOG2E;
#ifndef MK_PER_PHASE
#define MK_PER_PHASE 0
#endif
constexpr int N_PHASES = 15;
constexpr size_t MiB = 1u << 20;
constexpr size_t WS_CTL = 0;
constexpr size_t WS_MOD = 1 * MiB;
constexpr size_t WS_LOGF = 2 * MiB;
constexpr size_t WS_FC = 3 * MiB;
constexpr size_t WS_PART = 65536;
constexpr size_t WS_BIAS2 = 217 * MiB;
constexpr size_t WS_WQKV = 4 * MiB, WS_WO0 = 10 * MiB, WS_WIN0 = 12 * MiB, WS_WDN0 = 23 * MiB, WS_WKV = 29 * MiB, WS_WQ1 = 33 * MiB, WS_WO1 = 35 * MiB, WS_WIN1 = 37 * MiB, WS_WDN1 = 48 * MiB;
constexpr size_t WS_HA = 56 * MiB, WS_HQ = 88 * MiB;
constexpr size_t WS_Q = 120 * MiB, WS_K = 152 * MiB, WS_V = 184 * MiB;
constexpr size_t WS_ACT = 120 * MiB;
constexpr size_t WS_END = 218 * MiB;
static_assert(WS_WDN1 + (size_t)D * FF * 2 <= WS_HA && WS_ACT + (size_t)M * FF * 2 <= WS_BIAS2 && WS_WQ1 == WS_WKV + (size_t)2048 * D * 2 && WS_HQ == WS_HA + (size_t)M * D * 2, "d_ws map");
constexpr int RING_BYTES = 131072, LDS_BYTES = 147456;

#define LAS __attribute__((address_space(3)))
typedef unsigned short bf16;
typedef unsigned v4u __attribute__((ext_vector_type(4)));
typedef float f32x4 __attribute__((ext_vector_type(4)));
#define LDS_WAIT() asm volatile("s_waitcnt lgkmcnt(0)" ::: "memory")
__device__ __forceinline__ unsigned f2bf(float f) { unsigned u = __builtin_bit_cast(unsigned, f); return (u + 0x7fffu + ((u >> 16) & 1u)) >> 16; }
__device__ __forceinline__ unsigned pk2(float lo, float hi) { return f2bf(lo) | (f2bf(hi) << 16); }
__device__ __forceinline__ float wave_sum(float v) {
#pragma unroll
    for (int o = 1; o < 64; o <<= 1) v += __shfl_xor(v, o);
    return v;
}
struct Args { const float* in[19]; float* out; unsigned char* ws; int ph_lo, ph_hi; };

__device__ __forceinline__ void transpose_item(const float* W, int ldw, bf16* WT, int Kd, int drow0, int k0, int n0, LAS float* scr, int lane) {
    float tv[32];
#pragma unroll
    for (int i = 0; i < 32; ++i) { const int kk = 2 * i + (lane >> 5); tv[i] = W[(size_t)(k0 + kk) * ldw + n0 + (lane & 31)]; }
#pragma unroll
    for (int i = 0; i < 32; ++i) { const int kk = 2 * i + (lane >> 5); scr[kk * 33 + (lane & 31)] = tv[i]; }
    LDS_WAIT(); asm volatile("" ::: "memory");
    const int c = lane & 7;
#pragma unroll
    for (int j = 0; j < 4; ++j) { const int n = (lane >> 3) + 8 * j; const LAS float* s = scr + (8 * c) * 33 + n;
        v4u o; o.x = pk2(s[0 * 33], s[1 * 33]); o.y = pk2(s[2 * 33], s[3 * 33]); o.z = pk2(s[4 * 33], s[5 * 33]); o.w = pk2(s[6 * 33], s[7 * 33]);
        *(v4u*)(WT + (size_t)(drow0 + n) * Kd + k0 + 8 * c) = o; }
    LDS_WAIT(); asm volatile("" ::: "memory");
}
__device__ __forceinline__ int row_map(int kind, int n0) {
    if (kind == 1) { const int up = n0 >= FF; const int j = up ? n0 - FF : n0; return 256 * (j >> 7) + (up ? 128 : 0) + (j & 127); }
    if (kind == 2 && n0 < 1024) { const int p = n0 >> 8, w = (n0 >> 6) & 3, jj = (n0 >> 5) & 1; return 256 * p + 128 * jj + 32 * w; }
    return n0;
}
__device__ __forceinline__ void transpose_weights(const Args& a, LAS unsigned char* lds, int lane, int w, int nw, int mat_lo, int mat_hi) {
    LAS float* scr = (LAS float*)(lds + (threadIdx.x >> 6) * 16384);
    for (int it = w; ; it += nw) {
        int r = it, mi = mat_lo; const float* W = nullptr; int ldw = 0, ncb = 0, Kd = 0, kind = 0; bf16* WT = nullptr;
        for (; mi < mat_hi; ++mi) {
            switch (mi) {
                case 0: W = a.in[8]; ldw = 3 * D; ncb = 96; Kd = D; kind = 0; WT = (bf16*)(a.ws + WS_WQKV); break;
                case 1: W = a.in[9]; ldw = D; ncb = 32; Kd = D; kind = 0; WT = (bf16*)(a.ws + WS_WO0); break;
                case 2: W = a.in[6]; ldw = 2 * FF; ncb = 176; Kd = D; kind = 1; WT = (bf16*)(a.ws + WS_WIN0); break;
                case 3: W = a.in[7]; ldw = D; ncb = 32; Kd = FF; kind = 0; WT = (bf16*)(a.ws + WS_WDN0); break;
                case 4: W = a.in[13]; ldw = 2 * D + H; ncb = 64; Kd = D; kind = 2; WT = (bf16*)(a.ws + WS_WKV); break;
                case 5: W = a.in[16]; ldw = D; ncb = 32; Kd = D; kind = 2; WT = (bf16*)(a.ws + WS_WQ1); break;
                case 6: W = a.in[18]; ldw = D; ncb = 32; Kd = D; kind = 0; WT = (bf16*)(a.ws + WS_WO1); break;
                case 7: W = a.in[6] + (size_t)D * 2 * FF; ldw = 2 * FF; ncb = 176; Kd = D; kind = 1; WT = (bf16*)(a.ws + WS_WIN1); break;
                default: W = a.in[7] + (size_t)FF * D; ldw = D; ncb = 32; Kd = FF; kind = 0; WT = (bf16*)(a.ws + WS_WDN1); break;
            }
            const int items = (Kd / 64) * ncb; if (r < items) break; r -= items;
        }
        if (mi >= mat_hi) break;
        const int kb = r / ncb, nb = r % ncb;
        transpose_item(W, ldw, WT, Kd, row_map(kind, 32 * nb), 64 * kb, 32 * nb, scr, lane);
    }
}
__device__ __forceinline__ void prologue(const Args& a, LAS unsigned char* lds, int tid, int lane, int wave, int G) {
    const int bx = blockIdx.x;
    float* mod = (float*)(a.ws + WS_MOD);
    if (bx < 224) {
        LAS float* ca = (LAS float*)lds; LAS float* red = (LAS float*)(lds + 8192);
        for (int i = tid; i < 2 * D; i += 512) { const float v = a.in[1][i]; ca[i] = v / (1.f + __expf(-v)); }
        __syncthreads();
        const float* W; int N, col0; const float* bias; float* dst; int dstride;
        if (bx < 96) { W = a.in[2]; N = 6 * D; col0 = 64 * bx; bias = a.in[3] + col0; dst = mod + col0; dstride = 6 * D; }
        else if (bx < 192) { W = a.in[2] + (size_t)D * 6 * D; N = 6 * D; col0 = 64 * (bx - 96); bias = a.in[3] + 6 * D + col0; dst = mod + 2 * 6 * D + col0; dstride = 6 * D; }
        else { W = a.in[10]; N = 2 * D; col0 = 64 * (bx - 192); bias = a.in[11] + col0; dst = mod + 4 * 6 * D + col0; dstride = 2 * D; }
        const int rg = lane >> 4, cq = lane & 15; f32x4 a0 = {0.f, 0.f, 0.f, 0.f}, a1 = {0.f, 0.f, 0.f, 0.f}; const float* wp = W + (size_t)(128 * wave + rg) * N + col0 + 4 * cq;
#pragma unroll
        for (int h2 = 0; h2 < 2; ++h2) { f32x4 wv[16];
#pragma unroll
            for (int k = 0; k < 16; ++k) wv[k] = *(const f32x4*)(wp + (size_t)(4 * (16 * h2 + k)) * N);
#pragma unroll
            for (int k = 0; k < 16; ++k) { const int kr = 128 * wave + 4 * (16 * h2 + k) + rg; a0 += wv[k] * ca[kr]; a1 += wv[k] * ca[D + kr]; } }
#pragma unroll
        for (int e = 0; e < 4; ++e) { a0[e] += __shfl_xor(a0[e], 16); a0[e] += __shfl_xor(a0[e], 32); a1[e] += __shfl_xor(a1[e], 16); a1[e] += __shfl_xor(a1[e], 32); }
        if (rg == 0) { *(LAS f32x4*)(red + (wave * 2 + 0) * 64 + 4 * cq) = a0; *(LAS f32x4*)(red + (wave * 2 + 1) * 64 + 4 * cq) = a1; }
        __syncthreads();
        if (tid < 128) { const int b = tid >> 6, c = tid & 63; float s = 0.f;
#pragma unroll
            for (int w = 0; w < 8; ++w) s += red[(w * 2 + b) * 64 + c];
            dst[(size_t)b * dstride + c] = s + bias[c]; }
        __syncthreads();
    }
    transpose_weights(a, lds, lane, bx * NWAVES + wave, G * NWAVES, 0, 4);
}
__device__ __forceinline__ void norm_phase(const float* x, bf16* out, const float* g, const float* shift, const float* scale, int bstride, int gw, int NGW, int lane) {
    constexpr int NR = 4; f32x4 ca[4], cs[4]; int curb = -1;
    for (int m0 = gw; m0 < M; m0 += NR * NGW) {
        f32x4 v[NR][4]; float s[NR];
#pragma unroll
        for (int r = 0; r < NR; ++r) { const int m = m0 + r * NGW; if (m < M) { const f32x4* xr = (const f32x4*)(x + (size_t)m * D) + lane;
#pragma unroll
            for (int j = 0; j < 4; ++j) v[r][j] = xr[64 * j]; } }
#pragma unroll
        for (int r = 0; r < NR; ++r) { s[r] = 0.f; if (m0 + r * NGW < M) {
#pragma unroll
            for (int j = 0; j < 4; ++j) s[r] += (v[r][j].x * v[r][j].x + v[r][j].y * v[r][j].y) + (v[r][j].z * v[r][j].z + v[r][j].w * v[r][j].w); } }
#pragma unroll
        for (int o = 1; o < 64; o <<= 1)
#pragma unroll
            for (int r = 0; r < NR; ++r) s[r] += __shfl_xor(s[r], o);
#pragma unroll
        for (int r = 0; r < NR; ++r) { const int m = m0 + r * NGW; if (m < M) {
            const int b = m >> 13;
            if (b != curb) { curb = b;
#pragma unroll
                for (int j = 0; j < 4; ++j) { const int c = 256 * j + 4 * lane; ca[j] = *(const f32x4*)(g + c) * (1.0f + *(const f32x4*)(scale + (size_t)b * bstride + c)); cs[j] = *(const f32x4*)(shift + (size_t)b * bstride + c); } }
            const float rstd = 1.0f / sqrtf(s[r] * (1.f / D) + RMS_EPS);
            unsigned long long* o8 = (unsigned long long*)(out + (size_t)m * D) + lane;
#pragma unroll
            for (int j = 0; j < 4; ++j) { const f32x4 y = v[r][j] * rstd * ca[j] + cs[j]; o8[64 * j] = (unsigned long long)pk2(y.x, y.y) | ((unsigned long long)pk2(y.z, y.w) << 32); } } }
    }
}
__device__ __forceinline__ void bias2_phase(unsigned char* ws, int gw, int NGW, int lane, int layer) {
    const float* mod = (const float*)(ws + WS_MOD); float* b2 = (float*)(ws + WS_BIAS2);
    constexpr int NB = 6; v4u w0[NB], w1[NB];
    for (int it0 = gw + layer * 5632; it0 < (layer + 1) * 5632; it0 += NB * NGW) {
#pragma unroll
        for (int j = 0; j < NB; ++j) { const int it = it0 + j * NGW; if (it < (layer + 1) * 5632) { const int l = it / 5632, rho = it % 5632; const bf16* wrow = (const bf16*)(ws + (l ? WS_WIN1 : WS_WIN0)) + (size_t)rho * D + 16 * lane;
            w0[j] = *(const v4u*)wrow; w1[j] = *(const v4u*)(wrow + 8); } }
#pragma unroll
        for (int j = 0; j < NB; ++j) { const int it = it0 + j * NGW; if (it < (layer + 1) * 5632) { const int l = it / 5632, rho = it % 5632;
            const unsigned wu[8] = {w0[j].x, w0[j].y, w0[j].z, w0[j].w, w1[j].x, w1[j].y, w1[j].z, w1[j].w};
            float a0 = 0.f, a1 = 0.f; const float* s0 = mod + (size_t)(l * 2 + 0) * 6 * D + 3 * D + 16 * lane; const float* s1 = s0 + 6 * D;
#pragma unroll
            for (int k = 0; k < 8; ++k) { const float lo = __uint_as_float(wu[k] << 16), hi = __uint_as_float(wu[k] & 0xffff0000u);
                a0 += s0[2 * k] * lo + s0[2 * k + 1] * hi; a1 += s1[2 * k] * lo + s1[2 * k + 1] * hi; }
            a0 = wave_sum(a0); a1 = wave_sum(a1);
            if (lane == 0) { b2[(size_t)(l * 2 + 0) * 5632 + rho] = a0; b2[(size_t)(l * 2 + 1) * 5632 + rho] = a1; } } }
    }
}
__device__ __forceinline__ void norm2_phase(const Args& a, LAS unsigned char* lds, int tid, int gw, int NGW, int lane) {
    const float* x = a.out; bf16* hK = (bf16*)(a.ws + WS_HA); bf16* hQ = (bf16*)(a.ws + WS_HQ); float* logf_out = (float*)(a.ws + WS_LOGF);
    const float* mod1 = (const float*)(a.ws + WS_MOD) + 2 * 6 * D; const float* kvmod = (const float*)(a.ws + WS_MOD) + 4 * 6 * D;
    LAS float* wf = (LAS float*)lds;
    { const float* Wf = a.in[13] + 2 * D; for (int k = tid; k < D; k += 512) { const float* src = Wf + (size_t)k * (2 * D + H);
#pragma unroll
        for (int c = 0; c < 16; ++c) wf[c * D + k] = src[c]; } }
    __syncthreads();
    f32x4 ka[4], ks[4], qa[4], qs[4]; int curb = -1; f32x4 vn[4], vn2[4];
    if (gw < M) { const f32x4* xr = (const f32x4*)(x + (size_t)gw * D) + lane;
#pragma unroll
        for (int j = 0; j < 4; ++j) vn[j] = xr[64 * j]; }
    if (gw + NGW < M) { const f32x4* xr = (const f32x4*)(x + (size_t)(gw + NGW) * D) + lane;
#pragma unroll
        for (int j = 0; j < 4; ++j) vn2[j] = xr[64 * j]; }
    for (int m = gw; m < M; m += NGW) {
        const int b = m >> 13;
        if (b != curb) { curb = b;
#pragma unroll
            for (int j = 0; j < 4; ++j) { const int c = 256 * j + 4 * lane;
                ka[j] = *(const f32x4*)(a.in[12] + c) * (1.0f + *(const f32x4*)(kvmod + b * 2 * D + D + c)); ks[j] = *(const f32x4*)(kvmod + b * 2 * D + c);
                qa[j] = *(const f32x4*)(a.in[4] + D + c) * (1.0f + *(const f32x4*)(mod1 + b * 6 * D + D + c)); qs[j] = *(const f32x4*)(mod1 + b * 6 * D + c); } }
        f32x4 v[4]; float s = 0.f;
#pragma unroll
        for (int j = 0; j < 4; ++j) { v[j] = vn[j]; vn[j] = vn2[j]; s += (v[j].x * v[j].x + v[j].y * v[j].y) + (v[j].z * v[j].z + v[j].w * v[j].w); }
        if (m + 2 * NGW < M) { const f32x4* xr = (const f32x4*)(x + (size_t)(m + 2 * NGW) * D) + lane;
#pragma unroll
            for (int j = 0; j < 4; ++j) vn2[j] = xr[64 * j]; }
        const float rstd = 1.0f / sqrtf(wave_sum(s) * (1.f / D) + RMS_EPS);
        unsigned long long* ok = (unsigned long long*)(hK + (size_t)m * D) + lane; unsigned long long* oq = (unsigned long long*)(hQ + (size_t)m * D) + lane;
        f32x4 yk[4];
#pragma unroll
        for (int j = 0; j < 4; ++j) { const f32x4 xn = v[j] * rstd; yk[j] = xn * ka[j] + ks[j]; const f32x4 yq = xn * qa[j] + qs[j];
            ok[64 * j] = (unsigned long long)pk2(yk[j].x, yk[j].y) | ((unsigned long long)pk2(yk[j].z, yk[j].w) << 32);
            oq[64 * j] = (unsigned long long)pk2(yq.x, yq.y) | ((unsigned long long)pk2(yq.z, yq.w) << 32); }
        float part[16];
#pragma unroll
        for (int cg = 0; cg < 4; ++cg) {
#pragma unroll
            for (int c4 = 0; c4 < 4; ++c4) { const int c = 4 * cg + c4; float p = 0.f;
#pragma unroll
                for (int j = 0; j < 4; ++j) { const f32x4 w = *(const LAS f32x4*)(wf + c * D + 256 * j + 4 * lane); p += (yk[j].x * w.x + yk[j].y * w.y) + (yk[j].z * w.z + yk[j].w * w.w); }
                part[c] = p; }
            asm volatile("" ::: "memory");
        }
        float q8[8], q4[4], q2[2], q1;
        { const bool up = (lane & 32) != 0;
#pragma unroll
          for (int c = 0; c < 8; ++c) { const float keep = up ? part[c + 8] : part[c], send = up ? part[c] : part[c + 8]; q8[c] = keep + __shfl_xor(send, 32); } }
        { const bool up = (lane & 16) != 0;
#pragma unroll
          for (int c = 0; c < 4; ++c) { const float keep = up ? q8[c + 4] : q8[c], send = up ? q8[c] : q8[c + 4]; q4[c] = keep + __shfl_xor(send, 16); } }
        { const bool up = (lane & 8) != 0;
#pragma unroll
          for (int c = 0; c < 2; ++c) { const float keep = up ? q4[c + 2] : q4[c], send = up ? q4[c] : q4[c + 2]; q2[c] = keep + __shfl_xor(send, 8); } }
        { const bool up = (lane & 4) != 0; const float keep = up ? q2[1] : q2[0], send = up ? q2[0] : q2[1]; q1 = keep + __shfl_xor(send, 4); }
        q1 += __shfl_xor(q1, 2); q1 += __shfl_xor(q1, 1);
        if ((lane & 3) == 0) { const int c = ((lane >> 5) & 1) * 8 + ((lane >> 4) & 1) * 4 + ((lane >> 3) & 1) * 2 + ((lane >> 2) & 1);
            const float y = q1 + a.in[14][c]; const float lf = -(fmaxf(-y, 0.f) + log1pf(expf(-fabsf(y)))); logf_out[((size_t)b * H + c) * T + (m & (T - 1))] = lf; }
    }
    __syncthreads();
}
__device__ __forceinline__ void scan_seq(const float* src, float* dst, LAS unsigned char* lds, int tid, int lane, int wave) {
    LAS float* wt = (LAS float*)lds;
    f32x4 v[4]; const f32x4* s4 = (const f32x4*)(src + 16 * tid);
#pragma unroll
    for (int j = 0; j < 4; ++j) v[j] = s4[j];
    float run = 0.f;
#pragma unroll
    for (int j = 0; j < 4; ++j) { v[j].x += run; v[j].y += v[j].x; v[j].z += v[j].y; v[j].w += v[j].z; run = v[j].w; }
    float xs = run;
#pragma unroll
    for (int off = 1; off < 64; off <<= 1) { const float y = __shfl_up(xs, off); if (lane >= off) xs += y; }
    if (lane == 63) wt[wave] = xs;
    __syncthreads();
    float woff = 0.f;
#pragma unroll
    for (int w = 0; w < 8; ++w) woff += (w < wave) ? wt[w] : 0.f;
    const float offs = woff + xs - run;
    f32x4* d4 = (f32x4*)(dst + 16 * tid);
#pragma unroll
    for (int j = 0; j < 4; ++j) d4[j] = (v[j] + offs) * LOG2E;
    __syncthreads();
}

#define XB_TMO      128
#define XB_XCNT(j)  (256  + 64 * (j))
#define XB_XSUB(j)  (1280 + 64 * (j))
#define XB_XGEN(j)  (2304 + 64 * (j))
#define XB_TOP      3328
#define XB_TOPGEN   3392
#define XCD_BAR_WORDS 3456
#define XB_SPIN_CAP (1u << 18)

__device__ __forceinline__ unsigned xb_ld(unsigned* p)              { return __hip_atomic_load(p, __ATOMIC_RELAXED, __HIP_MEMORY_SCOPE_AGENT); }
__device__ __forceinline__ unsigned xb_add(unsigned* p, unsigned v) { return __hip_atomic_fetch_add(p, v, __ATOMIC_RELAXED, __HIP_MEMORY_SCOPE_AGENT); }
__device__ __forceinline__ unsigned xb_xcc_id() { return (unsigned)__builtin_amdgcn_s_getreg((3 << 11) | 20) & 0xFu; }
#define XB_SPIN(cond, bar) do { unsigned _sp = 0; while (cond) { __builtin_amdgcn_s_sleep(1); \
    if ((++_sp & 255u) == 0u) { if (xb_ld(&(bar)[XB_TMO])) break; if (_sp > XB_SPIN_CAP) { atomicAdd(&(bar)[XB_TMO], 1u); break; } } } } while (0)

struct XcdBarrier {
    unsigned* bar; unsigned x;
    volatile LAS unsigned* st;
};

__device__ __forceinline__ XcdBarrier xcd_barrier_post(unsigned* bar, volatile LAS unsigned* st) {
    XcdBarrier b; b.bar = bar; b.x = xb_xcc_id(); b.st = st;
    if (threadIdx.x == 0) (void)xb_add(&bar[XB_XCNT(b.x)], 1u);
    return b;
}
__device__ __forceinline__ void xcd_barrier_complete(unsigned* bar, unsigned x, unsigned& nloc, unsigned& nx) {
    const unsigned G = gridDim.x * gridDim.y * gridDim.z;
    unsigned sum, cnt, mine, sp = 0u;
    for (;;) {
        sum = 0u; cnt = 0u; mine = 0u;
#pragma unroll
        for (unsigned j = 0; j < 16; ++j) { const unsigned c = xb_ld(&bar[XB_XCNT(j)]); sum += c; cnt += (c > 0u) ? 1u : 0u; mine = (j == x) ? c : mine; }
        if (sum == G) break;
        __builtin_amdgcn_s_sleep(1);
        if ((++sp & 255u) == 0u) { if (xb_ld(&bar[XB_TMO])) break; if (sp > XB_SPIN_CAP) { atomicAdd(&bar[XB_TMO], 1u); break; } }
    }
    nloc = mine > 0u ? mine : 1u; nx = cnt > 0u ? cnt : 1u;
}

__device__ __forceinline__ void xcd_barrier(const XcdBarrier& b) {
    asm volatile("s_waitcnt vmcnt(0)" ::: "memory");
    __syncthreads();
    if (threadIdx.x == 0) {
        unsigned* bar = b.bar;
        __builtin_amdgcn_s_waitcnt(0);
        unsigned nloc = b.st[0], nx = b.st[1];
        if (nloc == 0u) { xcd_barrier_complete(bar, b.x, nloc, nx); b.st[0] = nloc; b.st[1] = nx; }
        const unsigned old = xb_add(&bar[XB_XSUB(b.x)], 1u);
        const unsigned gen = old / nloc;
        if (old + 1u == (gen + 1u) * nloc) {
            __builtin_amdgcn_fence(__ATOMIC_RELEASE, "agent");
            asm volatile("s_waitcnt vmcnt(0)" ::: "memory");
            const unsigned og = xb_add(&bar[XB_TOP], 1u);
            const unsigned tg = og / nx;
            if (og + 1u == (tg + 1u) * nx) xb_add(&bar[XB_TOPGEN], 1u);
            else XB_SPIN(xb_ld(&bar[XB_TOPGEN]) == tg, bar);
            __builtin_amdgcn_fence(__ATOMIC_ACQUIRE, "agent");
            xb_add(&bar[XB_XGEN(b.x)], 1u);
            asm volatile("s_waitcnt vmcnt(0)" ::: "memory");
        } else {
            XB_SPIN(xb_ld(&bar[XB_XGEN(b.x)]) == gen, bar);
            __builtin_amdgcn_fence(__ATOMIC_ACQUIRE, "agent");
            asm volatile("s_waitcnt vmcnt(0)" ::: "memory");
        }
    }
    __syncthreads();
}


constexpr int CW_BAR = 4096;
constexpr size_t CTL_ZERO_BYTES = 65536 + 2 * 16384 * 4;
__global__ void __launch_bounds__(NWAVES * 64, 2) yoco_fwd(Args args) {
    extern __shared__ __attribute__((aligned(16))) unsigned char lds_raw[];
    LAS unsigned char* lds = (LAS unsigned char*)lds_raw;
    const int tid = threadIdx.x, lane = tid & 63, wave = __builtin_amdgcn_readfirstlane(tid >> 6);
    const int G = gridDim.x, bx = blockIdx.x; const int gw = bx * NWAVES + wave, NGW = G * NWAVES;
    unsigned char* ws = args.ws;
    const float* mod = (const float*)(ws + WS_MOD);
    bf16 *hA = (bf16*)(ws + WS_HA), *hQb = (bf16*)(ws + WS_HQ), *Qb = (bf16*)(ws + WS_Q), *Kb = (bf16*)(ws + WS_K), *Vb = (bf16*)(ws + WS_V), *ACT = (bf16*)(ws + WS_ACT);
    const int lo = args.ph_lo, hi = args.ph_hi;
#define LANE() ({ int l_ = tid & 63; asm volatile("" : "+v"(l_)); l_; })
#ifndef RPT_MASK
#define RPT_MASK 0
#endif
#ifndef PH_MASK
#define PH_MASK 0x7fff
#endif
#define IN(k) (((PH_MASK >> (k)) & 1) && lo <= (k) && (k) < hi)
    { volatile LAS unsigned* st = (volatile LAS unsigned*)(lds + LDS_BYTES - 64); if (tid < 4) st[tid] = 0u; }
    __syncthreads();
    XcdBarrier bar = xcd_barrier_post((unsigned*)(ws + WS_CTL) + CW_BAR, (volatile LAS unsigned*)(lds + LDS_BYTES - 64));
    if (args.ph_hi > 1000) cg::this_grid().sync();
#define SEAM(k) do { if (IN(k) && (k) + 1 < hi) xcd_barrier(bar); } while (0)
    if (IN(0)) { for (int rep_ = 0; rep_ <= ((RPT_MASK >> 0) & 1); ++rep_) { if (rep_) xcd_barrier(bar); prologue(args, lds, tid, LANE(), wave, G); } } SEAM(0);
    if (IN(1)) { for (int rep_ = 0; rep_ <= ((RPT_MASK >> 1) & 1); ++rep_) { if (rep_) xcd_barrier(bar); norm_phase(args.in[0], hA, args.in[4], mod, mod + D, 6 * D, gw, NGW, LANE()); bias2_phase(ws, gw, NGW, LANE(), 0); } } SEAM(1);
    if (IN(2)) { for (int rep_ = 0; rep_ <= ((RPT_MASK >> 2) & 1); ++rep_) { if (rep_) xcd_barrier(bar); pg8::Gemm g{hA, (const bf16*)(ws + WS_WQKV), M, 3 * D, D}; pg8::StaticOrder S; S.init(M, 3 * D, G, bx);
        pg8::EpiQKV E{Qb, (size_t)(WS_K - WS_Q) / 2, QSCALE}; pg8::gemm_phase<pg8::EpiQKV, pg8::StaticOrder, true, true>(lds, g, S, E); } } SEAM(2);
    if (IN(3)) { for (int rep_ = 0; rep_ <= ((RPT_MASK >> 3) & 1); ++rep_) { if (rep_) xcd_barrier(bar); att::sb_wave_phase((ALAS char*)lds, Qb, Kb, Vb, hA, G, bx); } } SEAM(3);
    if (IN(4)) { for (int rep_ = 0; rep_ <= ((RPT_MASK >> 4) & 1); ++rep_) { if (rep_) xcd_barrier(bar); pg8::Gemm g{hA, (const bf16*)(ws + WS_WO0), M, D, D}; pg8::StaticOrder S; S.init(M, D, G, bx);
        pg8::EpiResN E{args.in[0], args.out, mod + 2 * D, 6 * D, hQb, args.in[5], mod + 4 * D, (float*)(ws + WS_PART)}; pg8::gemm_phase<pg8::EpiResN, pg8::StaticOrder, true, true>(lds, g, S, E); } } SEAM(4);
    if (IN(6)) { for (int rep_ = 0; rep_ <= ((RPT_MASK >> 6) & 1); ++rep_) { if (rep_) xcd_barrier(bar); pg8::Gemm g{hQb, (const bf16*)(ws + WS_WIN0), M, 2 * FF, D}; const unsigned ldsx = (unsigned)(uintptr_t)(lds + RING_BYTES);
        pg8::SwiOrder S{{}, (const float*)(ws + WS_PART), (const float*)(ws + WS_BIAS2), ldsx, 0}; S.so.init(M, 2 * FF, G, bx);
        pg8::EpiSwiGLU E{ACT, ldsx, RMS_EPS, 0}; pg8::gemm_phase<pg8::EpiSwiGLU, pg8::SwiOrder, true, true>(lds, g, S, E);
        if (G == 256) { if (bx >= 128) transpose_weights(args, lds, LANE(), (bx - 128) * NWAVES + wave, 128 * NWAVES, 4, 9); } else transpose_weights(args, lds, LANE(), gw, NGW, 4, 9); } } SEAM(6);
    if (IN(7)) { for (int rep_ = 0; rep_ <= ((RPT_MASK >> 7) & 1); ++rep_) { if (rep_) xcd_barrier(bar); pg8::Gemm g{ACT, (const bf16*)(ws + WS_WDN0), M, D, FF}; pg8::StaticOrder S; S.init(M, D, G, bx);
        pg8::EpiRes E{args.out, args.out, mod + 5 * D, 6 * D}; pg8::gemm_phase<pg8::EpiRes, pg8::StaticOrder, true, true>(lds, g, S, E); } } SEAM(7);
    if (IN(8)) { for (int rep_ = 0; rep_ <= ((RPT_MASK >> 8) & 1); ++rep_) { if (rep_) xcd_barrier(bar); norm2_phase(args, lds, tid, gw, NGW, LANE()); bias2_phase(ws, gw, NGW, LANE(), 1); } } SEAM(8);
    if (IN(9)) { for (int rep_ = 0; rep_ <= ((RPT_MASK >> 9) & 1); ++rep_) { if (rep_) xcd_barrier(bar);
        if (bx < BATCH * H) scan_seq((const float*)(ws + WS_LOGF) + (size_t)bx * T, (float*)(ws + WS_FC) + (size_t)bx * T, lds, tid, LANE(), wave);
        pg8::Gemm g{hA, (const bf16*)(ws + WS_WKV), 2 * M, 3 * D, D}; pg8::StackOrder S{G, bx};
        pg8::EpiKVQ E{Kb, Vb, Qb, args.in[15], args.in[17], QSCALE, RMS_EPS}; pg8::gemm_phase<pg8::EpiKVQ, pg8::StackOrder, true, true>(lds, g, S, E); } } SEAM(9);
    if (IN(10)) { for (int rep_ = 0; rep_ <= ((RPT_MASK >> 10) & 1); ++rep_) { if (rep_) xcd_barrier(bar); att::attn_phase<1>((ALAS char*)lds, Qb, Kb, Vb, hA, (const float*)(ws + WS_FC), args.in[15], (unsigned*)(ws + WS_CTL) + 64 + 128 * rep_); } } SEAM(10);
    if (IN(11)) { for (int rep_ = 0; rep_ <= ((RPT_MASK >> 11) & 1); ++rep_) { if (rep_) xcd_barrier(bar); pg8::Gemm g{hA, (const bf16*)(ws + WS_WO1), M, D, D}; pg8::StaticOrder S; S.init(M, D, G, bx);
        pg8::EpiResN E{args.out, args.out, mod + 2 * 6 * D + 2 * D, 6 * D, hQb, args.in[5] + D, mod + 2 * 6 * D + 4 * D, (float*)(ws + WS_PART) + M}; pg8::gemm_phase<pg8::EpiResN, pg8::StaticOrder, true, true>(lds, g, S, E); } } SEAM(11);
    if (IN(13)) { for (int rep_ = 0; rep_ <= ((RPT_MASK >> 13) & 1); ++rep_) { if (rep_) xcd_barrier(bar); pg8::Gemm g{hQb, (const bf16*)(ws + WS_WIN1), M, 2 * FF, D}; const unsigned ldsx = (unsigned)(uintptr_t)(lds + RING_BYTES);
        pg8::SwiOrder S{{}, (const float*)(ws + WS_PART) + M, (const float*)(ws + WS_BIAS2) + 2 * 5632, ldsx, 0}; S.so.init(M, 2 * FF, G, bx);
        pg8::EpiSwiGLU E{ACT, ldsx, RMS_EPS, 0}; pg8::gemm_phase<pg8::EpiSwiGLU, pg8::SwiOrder, true, true>(lds, g, S, E); } } SEAM(13);
    if (IN(14)) { for (int rep_ = 0; rep_ <= ((RPT_MASK >> 14) & 1); ++rep_) { if (rep_) xcd_barrier(bar); pg8::Gemm g{ACT, (const bf16*)(ws + WS_WDN1), M, D, FF}; pg8::StaticOrder S; S.init(M, D, G, bx);
        pg8::EpiRes E{args.out, args.out, mod + 2 * 6 * D + 5 * D, 6 * D}; pg8::gemm_phase<pg8::EpiRes, pg8::StaticOrder, true, true>(lds, g, S, E); } }
#undef IN
#undef SEAM
}

extern "C" void kernel_launch(void* const* d_in, const int* in_sizes, int n_in, void* d_out, int out_size, void* d_ws, size_t ws_size, hipStream_t stream) {
    static int grid = 0;
    if (grid == 0) {
        if (n_in != 19 || out_size != M * D || ws_size < WS_END) { fprintf(stderr, "kernel_launch: unexpected shapes (n_in %d, out %d, ws %zu)\n", n_in, out_size, ws_size); grid = -1; return; }
        int dev = 0, cus = 0, per_cu = 0;
        (void)hipGetDevice(&dev); (void)hipDeviceGetAttribute(&cus, hipDeviceAttributeMultiprocessorCount, dev);
        if (hipFuncSetAttribute((const void*)yoco_fwd, hipFuncAttributeMaxDynamicSharedMemorySize, LDS_BYTES) != hipSuccess) { fprintf(stderr, "kernel_launch: hipFuncSetAttribute failed\n"); grid = -1; return; }
        if (hipOccupancyMaxActiveBlocksPerMultiprocessor(&per_cu, (const void*)yoco_fwd, NWAVES * 64, LDS_BYTES) != hipSuccess || per_cu < 1) { fprintf(stderr, "kernel_launch: occupancy query says %d\n", per_cu); per_cu = 1; }
        (void)hipGetLastError();
        grid = cus;
    }
    if (grid < 0) return;
    if (hipMemsetAsync((char*)d_ws + WS_CTL, 0, CTL_ZERO_BYTES, stream) != hipSuccess) { fprintf(stderr, "kernel_launch: memset failed\n"); return; }
    Args a{};
    for (int i = 0; i < 19; ++i) a.in[i] = (const float*)d_in[i];
    a.out = (float*)d_out; a.ws = (unsigned char*)d_ws;
#if MK_PER_PHASE
    for (int p = 0; p < N_PHASES; ++p) { a.ph_lo = p; a.ph_hi = p + 1; hipLaunchKernelGGL(yoco_fwd, dim3(grid), dim3(NWAVES * 64), LDS_BYTES, stream, a); }
#else
    a.ph_lo = 0; a.ph_hi = N_PHASES;
    void* kargs[] = {&a};
    const hipError_t e = hipLaunchCooperativeKernel((const void*)yoco_fwd, dim3(grid), dim3(NWAVES * 64), kargs, LDS_BYTES, stream);
    if (e != hipSuccess) fprintf(stderr, "kernel_launch: cooperative launch failed: %s (grid %d)\n", hipGetErrorString(e), grid);
#endif
}
```

```cpp
#include <hip/hip_runtime.h>
#include <hip/hip_cooperative_groups.h>
#include <cstdio>
#include <cstdint>
namespace cg = cooperative_groups;
namespace pg8 {
#define PG8_LAS __attribute__((address_space(3)))
typedef unsigned short bf16_t;
typedef short bf16x8 __attribute__((ext_vector_type(8)));
typedef float f32x4 __attribute__((ext_vector_type(4)));
typedef unsigned u32x4 __attribute__((ext_vector_type(4)));
constexpr int BM = 256, BK = 64, HALF = 128, HTB = HALF * BK * 2  , STAGE_BYTES = 8 * HTB, NXCD = 8, WGM = 8;

__host__ __device__ __forceinline__ int lds_byte(int r, int c) { const int st = (r >> 4) * 2 + (c >> 5), rr = r & 15, cc = c & 31, ob = rr * 64 + cc * 2; return st * 1024 + (ob ^ (((ob >> 9) & 1) << 5)); }
__host__ __device__ __forceinline__ void stage_rc(int b, int& R, int& C) { const int st = b / 1024, sb = b % 1024, swz = sb ^ (((sb >> 9) & 1) << 5); R = (st >> 1) * 16 + swz / 64; C = (st & 1) * 32 + (swz % 64) / 2; }
__host__ __device__ __forceinline__ int perm32(int rho) { const int n = rho >> 4, i = rho & 15; return 8 * (i >> 2) + 4 * n + (i & 3); }

struct Unit { int pm, pn; };
struct Gemm { const bf16_t* A; const bf16_t* Bt; int M, N, K; };

struct StaticOrder {
    int nM, nN, nwg, G, c;
    __host__ __device__ void init(int M, int N, int G_, int c_) { nM = M / BM; nN = N / BM; nwg = nM * nN; G = G_; c = c_; }
    __host__ __device__ bool next(int i, Unit& u) const {
        const long L = (long)i * G + c; if (L >= nwg) return false;
        int wgid = (int)L; { const int q = nwg / NXCD, r = nwg % NXCD, xcd = wgid % NXCD, off = wgid / NXCD; wgid = (xcd < r ? xcd * (q + 1) : r * (q + 1) + (xcd - r) * q) + off; }
        const int nig = WGM * nN, gid = wgid / nig, fm = gid * WGM, gsz = (nM - fm) < WGM ? (nM - fm) : WGM;
        u.pm = fm + ((wgid % nig) % gsz); u.pn = (wgid % nig) / gsz; return true;
    }
    __device__ __forceinline__ void a_ready(const Unit&) const {}
    __device__ __forceinline__ void done(const Unit&) const {}
};

}
namespace pg8 {
__device__ __forceinline__ unsigned cvt_pk_bf16(float lo, float hi) { unsigned r; asm volatile("v_cvt_pk_bf16_f32 %0, %1, %2" : "=v"(r) : "v"(lo), "v"(hi)); return r; }
struct EpiQKV {
    static constexpr bool PERM = true, AFTER_DRAIN = false;
    bf16_t* O; size_t split_stride; float scale0;
    __device__ __forceinline__ void operator()(const f32x4 (&acc)[2][2][4][2], const Unit& u, int wr, int wc, int fr, int fq) const {
        const int row0 = u.pm * BM + wr * 64 + fr; const int t = u.pn >> 2; bf16_t* base = O + (size_t)t * split_stride; const float sc = (t == 0) ? scale0 : 1.f;
        const int col0 = (u.pn & 3) * BM + wc * 32 + 8 * fq;
#pragma unroll
        for (int ai = 0; ai < 2; ++ai)
#pragma unroll
            for (int m = 0; m < 4; ++m) { bf16_t* rowp = base + (size_t)(row0 + ai * HALF + m * 16) * 1024 + col0;
#pragma unroll
                for (int bj = 0; bj < 2; ++bj) { const f32x4 v0 = acc[ai][bj][m][0] * sc, v1 = acc[ai][bj][m][1] * sc;
                    u32x4 w; w.x = cvt_pk_bf16(v0[0], v0[1]); w.y = cvt_pk_bf16(v0[2], v0[3]); w.z = cvt_pk_bf16(v1[0], v1[1]); w.w = cvt_pk_bf16(v1[2], v1[3]);
                    *(u32x4*)(rowp + bj * HALF) = w; } }
    }
};
struct EpiRes {
    static constexpr bool PERM = false, AFTER_DRAIN = false;
    const float* base; float* out; const float* gate; int gate_bstride;
    __device__ __forceinline__ void operator()(const f32x4 (&acc)[2][2][4][2], const Unit& u, int wr, int wc, int fr, int fq) const {
        const int b = (u.pm * BM) >> 13; const float* gp = gate + (size_t)b * gate_bstride;
        const int col0 = u.pn * BM + wc * 32 + 4 * fq;
        f32x4 gv[2][2];
#pragma unroll
        for (int bj = 0; bj < 2; ++bj)
#pragma unroll
            for (int n = 0; n < 2; ++n) gv[bj][n] = *(const f32x4*)(gp + col0 + bj * HALF + n * 16);
        f32x4 bsA[2][2][2], bsB[2][2][2];
#define ER_LOAD(dst, k) do { _Pragma("unroll") for (int m2 = 0; m2 < 2; ++m2) { const size_t off_ = (size_t)(u.pm * BM + ((k) >> 1) * HALF + wr * 64 + (2 * ((k) & 1) + m2) * 16 + fr) * 1024 + col0; \
            _Pragma("unroll") for (int bj = 0; bj < 2; ++bj) _Pragma("unroll") for (int n = 0; n < 2; ++n) dst[m2][bj][n] = *(const f32x4*)(base + off_ + bj * HALF + n * 16); } } while (0)
#define ER_STORE(src, k) do { _Pragma("unroll") for (int m2 = 0; m2 < 2; ++m2) { const size_t off_ = (size_t)(u.pm * BM + ((k) >> 1) * HALF + wr * 64 + (2 * ((k) & 1) + m2) * 16 + fr) * 1024 + col0; \
            _Pragma("unroll") for (int bj = 0; bj < 2; ++bj) _Pragma("unroll") for (int n = 0; n < 2; ++n) *(f32x4*)(out + off_ + bj * HALF + n * 16) = src[m2][bj][n] + gv[bj][n] * acc[(k) >> 1][bj][2 * ((k) & 1) + m2][n]; } } while (0)
        ER_LOAD(bsA, 0); ER_LOAD(bsB, 1); asm volatile("" ::: "memory");
        ER_STORE(bsA, 0); ER_LOAD(bsA, 2); asm volatile("" ::: "memory");
        ER_STORE(bsB, 1); ER_LOAD(bsB, 3); asm volatile("" ::: "memory");
        ER_STORE(bsA, 2); ER_STORE(bsB, 3);
#undef ER_LOAD
#undef ER_STORE
    }
};
struct EpiResN {
    static constexpr bool PERM = false, AFTER_DRAIN = false;
    const float* base; float* out; const float* gate; int gate_bstride; bf16_t* A2; const float* ng; const float* nscale; float* part;
    __device__ __forceinline__ void operator()(const f32x4 (&acc)[2][2][4][2], const Unit& u, int wr, int wc, int fr, int fq) const {
        const int b = (u.pm * BM) >> 13; const float* gp = gate + (size_t)b * gate_bstride; const float* sp = nscale + (size_t)b * gate_bstride;
        const int col0 = u.pn * BM + wc * 32 + 4 * fq;
        f32x4 gv[2][2], av[2][2];
#pragma unroll
        for (int bj = 0; bj < 2; ++bj)
#pragma unroll
            for (int n = 0; n < 2; ++n) { const int c = col0 + bj * HALF + n * 16; gv[bj][n] = *(const f32x4*)(gp + c); av[bj][n] = *(const f32x4*)(ng + c) * (1.0f + *(const f32x4*)(sp + c)); }
#pragma unroll
        for (int ai = 0; ai < 2; ++ai) {
          for (int mh = 0; mh < 2; ++mh) {
            f32x4 bs[4][2][2];
#pragma unroll
            for (int m = 2 * mh; m < 2 * mh + 2; ++m) { const size_t off = (size_t)(u.pm * BM + ai * HALF + wr * 64 + m * 16 + fr) * 1024 + col0;
#pragma unroll
                for (int bj = 0; bj < 2; ++bj)
#pragma unroll
                    for (int n = 0; n < 2; ++n) bs[m][bj][n] = *(const f32x4*)(base + off + bj * HALF + n * 16); }
            asm volatile("" ::: "memory");
#pragma unroll
            for (int m = 2 * mh; m < 2 * mh + 2; ++m) { const int row = u.pm * BM + ai * HALF + wr * 64 + m * 16 + fr; const size_t off = (size_t)row * 1024 + col0; float ss = 0.f;
#pragma unroll
                for (int bj = 0; bj < 2; ++bj)
#pragma unroll
                    for (int n = 0; n < 2; ++n) { const f32x4 x1 = bs[m][bj][n] + gv[bj][n] * acc[ai][bj][m][n];
                        *(f32x4*)(out + off + bj * HALF + n * 16) = x1; ss += (x1[0] * x1[0] + x1[1] * x1[1]) + (x1[2] * x1[2] + x1[3] * x1[3]);
                        const f32x4 y = x1 * av[bj][n]; unsigned long long w = (unsigned long long)cvt_pk_bf16(y[0], y[1]) | ((unsigned long long)cvt_pk_bf16(y[2], y[3]) << 32);
                        *(unsigned long long*)(A2 + off + bj * HALF + n * 16) = w; }
                ss += __shfl_xor(ss, 16); ss += __shfl_xor(ss, 32);
                if (fq == 0) __hip_atomic_fetch_add(part + row, ss, __ATOMIC_RELAXED, __HIP_MEMORY_SCOPE_AGENT); }
          }
        }
    }
};
__device__ __forceinline__ void glds4(const void* gsrc, unsigned lds_dst) { unsigned keep;
  asm volatile("s_mov_b32 %0, m0\n\ts_mov_b32 m0, %2\n\ts_nop 0\n\tglobal_load_lds_dword %1, off\n\ts_mov_b32 m0, %0" : "=&s"(keep) : "v"(gsrc), "s"(lds_dst) : "memory"); }
struct SwiOrder {
    StaticOrder so; const float* part; const float* bias2; unsigned ldsx; mutable int k;
    __device__ bool next(int i, Unit& u) const { return so.next(i, u); }
    __device__ __forceinline__ void a_ready(const Unit& u) const {
        const int wid = __builtin_amdgcn_readfirstlane(threadIdx.x >> 6), lane = threadIdx.x & 63; const unsigned dst = ldsx + (unsigned)((k & 1) * 2048 + wid * 256); ++k;
        const float* src = (wid < 4) ? part + u.pm * BM + wid * 64 + lane : bias2 + (size_t)((u.pm * BM) >> 13) * 5632 + u.pn * BM + (wid - 4) * 64 + lane;
        glds4(src, (unsigned)__builtin_amdgcn_readfirstlane(dst));
    }
    __device__ __forceinline__ void done(const Unit&) const {}
};
struct EpiSwiGLU {
    static constexpr bool PERM = true, AFTER_DRAIN = false;
    bf16_t* O; unsigned ldsx; float eps; mutable int k;
    __device__ __forceinline__ void operator()(const f32x4 (&acc)[2][2][4][2], const Unit& u, int wr, int wc, int fr, int fq) const {
        const int row0 = u.pm * BM + wr * 64 + fr; const int col0 = u.pn * 128 + wc * 32 + 8 * fq;
        const PG8_LAS float* xs = (const PG8_LAS float*)(size_t)(ldsx + (unsigned)((k & 1) * 2048)); ++k;
        f32x4 bv[2][2]; float rs[2][4];
#pragma unroll
        for (int ai = 0; ai < 2; ++ai)
#pragma unroll
            for (int m = 0; m < 4; ++m) rs[ai][m] = xs[ai * HALF + wr * 64 + m * 16 + fr];
#pragma unroll
        for (int bj = 0; bj < 2; ++bj)
#pragma unroll
            for (int n = 0; n < 2; ++n) bv[bj][n] = *(const PG8_LAS f32x4*)(xs + 256 + bj * HALF + wc * 32 + 8 * fq + 4 * n);
#pragma unroll
        for (int ai = 0; ai < 2; ++ai)
#pragma unroll
            for (int m = 0; m < 4; ++m) { const int row = row0 + ai * HALF + m * 16;
                const float rstd = __builtin_amdgcn_rsqf(rs[ai][m] * (1.0f / 1024.0f) + eps);
                bf16_t* rowp = O + (size_t)row * 2816 + col0; float r[8];
#pragma unroll
                for (int n = 0; n < 2; ++n)
#pragma unroll
                    for (int e = 0; e < 4; ++e) { const float g = acc[ai][0][m][n][e] * rstd + bv[0][n][e], up = acc[ai][1][m][n][e] * rstd + bv[1][n][e];
                        const float sg = __builtin_amdgcn_rcpf(1.f + __builtin_amdgcn_exp2f(-1.4426950408889634f * g)); r[n * 4 + e] = g * sg * up; }
                u32x4 w; w.x = cvt_pk_bf16(r[0], r[1]); w.y = cvt_pk_bf16(r[2], r[3]); w.z = cvt_pk_bf16(r[4], r[5]); w.w = cvt_pk_bf16(r[6], r[7]);
                *(u32x4*)rowp = w; }
    }
};
struct EpiKVQ {
    static constexpr bool PERM = true, AFTER_DRAIN = false;
    bf16_t *Kb, *Vb, *Qb; const float *kg, *qg; float qscale, eps;
    __device__ __forceinline__ void operator()(const f32x4 (&acc)[2][2][4][2], const Unit& u, int wr, int wc, int fr, int fq) const {
        const int kind = u.pn >> 2; const int pm = (kind == 2) ? u.pm - 64 : u.pm; const int row0 = pm * BM + wr * 64 + fr;
        if (kind == 1) {
            const int col0 = (u.pn & 3) * BM + wc * 32 + 8 * fq;
#pragma unroll
            for (int ai = 0; ai < 2; ++ai)
#pragma unroll
                for (int m = 0; m < 4; ++m) { bf16_t* rowp = Vb + (size_t)(row0 + ai * HALF + m * 16) * 1024 + col0;
#pragma unroll
                    for (int bj = 0; bj < 2; ++bj) { const f32x4 v0 = acc[ai][bj][m][0], v1 = acc[ai][bj][m][1];
                        u32x4 w; w.x = cvt_pk_bf16(v0[0], v0[1]); w.y = cvt_pk_bf16(v0[2], v0[3]); w.z = cvt_pk_bf16(v1[0], v1[1]); w.w = cvt_pk_bf16(v1[2], v1[3]);
                        *(u32x4*)(rowp + bj * HALF) = w; } }
        } else {
            bf16_t* Ob = (kind == 0) ? Kb : Qb; const float* gsrc = (kind == 0) ? kg : qg; const float sc = (kind == 0) ? 1.f : qscale;
            f32x4 gv[2][2];
#pragma unroll
            for (int bj = 0; bj < 2; ++bj)
#pragma unroll
                for (int n = 0; n < 2; ++n) gv[bj][n] = *(const f32x4*)(gsrc + bj * 32 + 8 * fq + 4 * n) * sc;
            const int col0 = (u.pn & 3) * BM + wc * 64 + 8 * fq;
#pragma unroll
            for (int ai = 0; ai < 2; ++ai)
#pragma unroll
                for (int m = 0; m < 4; ++m) { float ss = 0.f;
#pragma unroll
                    for (int bj = 0; bj < 2; ++bj)
#pragma unroll
                        for (int n = 0; n < 2; ++n) { const f32x4 v = acc[ai][bj][m][n]; ss += (v[0] * v[0] + v[1] * v[1]) + (v[2] * v[2] + v[3] * v[3]); }
                    ss += __shfl_xor(ss, 16); ss += __shfl_xor(ss, 32);
                    const float rstd = 1.0f / sqrtf(ss * (1.0f / 64.0f) + eps);
                    bf16_t* rowp = Ob + (size_t)(row0 + ai * HALF + m * 16) * 1024 + col0;
#pragma unroll
                    for (int bj = 0; bj < 2; ++bj) { const f32x4 v0 = acc[ai][bj][m][0] * rstd * gv[bj][0], v1 = acc[ai][bj][m][1] * rstd * gv[bj][1];
                        u32x4 w; w.x = cvt_pk_bf16(v0[0], v0[1]); w.y = cvt_pk_bf16(v0[2], v0[3]); w.z = cvt_pk_bf16(v1[0], v1[1]); w.w = cvt_pk_bf16(v1[2], v1[3]);
                        *(u32x4*)(rowp + bj * 32) = w; } }
        }
    }
};
struct StackOrder {
    int G, c;
    __device__ bool next(int i, Unit& u) const {
        const int nwg = 768; const long L = (long)i * G + c; if (L >= nwg) return false;
        int wgid = (int)L; { const int q = nwg / NXCD, xcd = wgid % NXCD, off = wgid / NXCD; wgid = xcd * q + off; }
        if (wgid < 512) { const int nN = 8, nig = WGM * nN, gid = wgid / nig; u.pm = gid * WGM + ((wgid % nig) % WGM); u.pn = (wgid % nig) / WGM; }
        else { const int w2 = wgid - 512; const int nN = 4, nig = WGM * nN, gid = w2 / nig; u.pm = 64 + gid * WGM + ((w2 % nig) % WGM); u.pn = 8 + (w2 % nig) / WGM; }
        return true;
    }
    __device__ __forceinline__ void a_ready(const Unit&) const {}
    __device__ __forceinline__ void done(const Unit&) const {}
};
}
namespace pg8 {
template <class Epi, class Sched, bool ALIGN_EPI = false, bool SP2 = false>
__device__ __forceinline__ void gemm_phase(PG8_LAS unsigned char* lds, const Gemm g, const Sched& S, const Epi& E) {
    const int tid = threadIdx.x, wid = __builtin_amdgcn_readfirstlane(tid >> 6), lane = tid & 63, wr = wid >> 2, wc = wid & 3, fr = lane & 15, fq = lane >> 4;
    const int K = g.K, nt = K / BK;
    unsigned voffA[2], voffB[2];
#pragma unroll
    for (int i = 0; i < 2; ++i) { int R, C; stage_rc(tid * 16 + i * 8192, R, C); const int Rb = Epi::PERM ? ((R & ~31) + perm32(R & 31)) : R;
        voffA[i] = (unsigned)(R * K + C) * 2u; voffB[i] = (unsigned)(Rb * K + C) * 2u; }
    const size_t kstep = (size_t)(BK * 2);
    const size_t hstep = (size_t)HALF * K * 2;
    const size_t tstep = 2 * hstep;
    const unsigned ldsw = (unsigned)wid * 1024u;
    const int aoff = lds_byte(wr * 64 + fr, fq * 8), boff = lds_byte(wc * 32 + fr, fq * 8);
#define PG8_SA(b, h) (((b) * 2 + (h)) * HTB)
#define PG8_SB(b, h) ((4 + (b) * 2 + (h)) * HTB)
#define PG8_STAGE(bufoff, gbase, voff) do { _Pragma("unroll") for (int _i = 0; _i < 2; ++_i) \
        __builtin_amdgcn_global_load_lds((const unsigned*)((const char*)(gbase) + (voff)[_i]), (PG8_LAS unsigned*)(lds + (bufoff) + ldsw + _i * 8192), 16, 0, 0); } while (0)
#define PG8_LDA(dst, b, h) do { _Pragma("unroll") for (int m = 0; m < 4; ++m) _Pragma("unroll") for (int k = 0; k < 2; ++k) dst[m][k] = *(const PG8_LAS bf16x8*)(lds + PG8_SA(b, h) + aoff + m * 2048 + k * 1024); } while (0)
#define PG8_LDB(dst, b, h) do { _Pragma("unroll") for (int n = 0; n < 2; ++n) _Pragma("unroll") for (int k = 0; k < 2; ++k) dst[n][k] = *(const PG8_LAS bf16x8*)(lds + PG8_SB(b, h) + boff + n * 2048 + k * 1024); } while (0)
#define PG8_MMA(ai, bj, At, Bt) do { __builtin_amdgcn_s_setprio(1); _Pragma("unroll") for (int m = 0; m < 4; ++m) _Pragma("unroll") for (int n = 0; n < 2; ++n) _Pragma("unroll") for (int k = 0; k < 2; ++k) \
        acc[ai][bj][m][n] = __builtin_amdgcn_mfma_f32_16x16x32_bf16(Bt[n][k], At[m][k], acc[ai][bj][m][n], 0, 0, 0); __builtin_amdgcn_s_setprio(0); } while (0)
#define PG8_WAIT_V(n) asm volatile("s_waitcnt vmcnt(" #n ")" ::: "memory")
#define PG8_WAIT_L(n) asm volatile("s_waitcnt lgkmcnt(" #n ")" ::: "memory")
#define PG8_BAR __builtin_amdgcn_s_barrier()
#define PG8_SCHED __builtin_amdgcn_sched_barrier(0)
    Unit cur, nxt; int ui = 0;
    if (!S.next(0, cur)) return;
    f32x4 acc[2][2][4][2];
#pragma unroll
    for (int a = 0; a < 2; ++a)
#pragma unroll
        for (int b = 0; b < 2; ++b)
#pragma unroll
            for (int m = 0; m < 4; ++m)
#pragma unroll
                for (int n = 0; n < 2; ++n) acc[a][b][m][n] = (f32x4){0.f, 0.f, 0.f, 0.f};
    bf16x8 At[4][2], B0[2][2], B1[2][2];
    const char* cA = (const char*)g.A + (size_t)cur.pm * tstep; const char* cB = (const char*)g.Bt + (size_t)cur.pn * tstep;
    S.a_ready(cur);
    if constexpr (SP2) {
        PG8_STAGE(PG8_SB(0, 0), cB, voffB); PG8_STAGE(PG8_SB(0, 1), cB + hstep, voffB); PG8_STAGE(PG8_SA(0, 0), cA, voffA); PG8_STAGE(PG8_SA(0, 1), cA + hstep, voffA);
        if (wr == 1) PG8_BAR;
        PG8_WAIT_V(2); PG8_BAR;
        PG8_STAGE(PG8_SB(1, 0), cB + kstep, voffB); PG8_STAGE(PG8_SA(1, 0), cA + kstep, voffA); PG8_STAGE(PG8_SB(1, 1), cB + hstep + kstep, voffB);
        PG8_WAIT_V(6); PG8_BAR;
    } else {
        PG8_STAGE(PG8_SB(0, 0), cB, voffB); PG8_STAGE(PG8_SA(0, 0), cA, voffA); PG8_STAGE(PG8_SB(0, 1), cB + hstep, voffB); PG8_STAGE(PG8_SA(0, 1), cA + hstep, voffA);
        if (wr == 1) PG8_BAR;
        PG8_WAIT_V(4); PG8_BAR;
        PG8_STAGE(PG8_SB(1, 0), cB + kstep, voffB); PG8_STAGE(PG8_SA(1, 0), cA + kstep, voffA); PG8_STAGE(PG8_SB(1, 1), cB + hstep + kstep, voffB);
        PG8_WAIT_V(6); PG8_BAR;
    }
    for (;;) {
        const bool has_next = S.next(ui + 1, nxt);
        const char* nA = has_next ? (const char*)g.A + (size_t)nxt.pm * tstep : cA; const char* nB = has_next ? (const char*)g.Bt + (size_t)nxt.pn * tstep : cB;
        for (int t = 0; t < nt; t += 2) {
            const bool last = (t == nt - 2);
            const char* a1 = cA + (size_t)(t + 1) * kstep;
            const char* a2 = last ? nA : cA + (size_t)(t + 2) * kstep; const char* b2 = last ? nB : cB + (size_t)(t + 2) * kstep;
            const char* a3 = a2 + kstep; const char* b3 = b2 + kstep;
            if (last && has_next) S.a_ready(nxt);
            if constexpr (SP2) {
            PG8_LDB(B0, 0, 0); PG8_LDB(B1, 0, 1); PG8_SCHED; PG8_LDA(At, 0, 0); PG8_STAGE(PG8_SA(1, 1), a1 + hstep, voffA);
            PG8_WAIT_V(8); PG8_WAIT_L(0); PG8_BAR; PG8_MMA(0, 0, At, B0); PG8_MMA(0, 1, At, B1); PG8_BAR; PG8_SCHED;
            PG8_LDA(At, 0, 1); PG8_STAGE(PG8_SB(0, 0), b2, voffB); PG8_STAGE(PG8_SB(0, 1), b2 + hstep, voffB); PG8_STAGE(PG8_SA(0, 0), a2, voffA);
            PG8_WAIT_V(8); PG8_WAIT_L(0); PG8_BAR; PG8_MMA(1, 0, At, B0); PG8_MMA(1, 1, At, B1); PG8_BAR; PG8_SCHED;
            PG8_LDB(B0, 1, 0); PG8_LDB(B1, 1, 1); PG8_SCHED; PG8_LDA(At, 1, 0); PG8_STAGE(PG8_SA(0, 1), a2 + hstep, voffA);
            PG8_WAIT_V(8); PG8_WAIT_L(0); PG8_BAR; PG8_MMA(0, 0, At, B0); PG8_MMA(0, 1, At, B1); PG8_BAR; PG8_SCHED;
            PG8_LDA(At, 1, 1); PG8_STAGE(PG8_SB(1, 0), b3, voffB); PG8_STAGE(PG8_SB(1, 1), b3 + hstep, voffB); PG8_STAGE(PG8_SA(1, 0), a3, voffA);
            PG8_WAIT_V(8); PG8_WAIT_L(0); PG8_BAR; PG8_MMA(1, 0, At, B0); PG8_MMA(1, 1, At, B1); PG8_BAR; PG8_SCHED;
            } else {
            PG8_LDB(B0, 0, 0); PG8_SCHED; PG8_LDA(At, 0, 0); PG8_STAGE(PG8_SA(1, 1), a1 + hstep, voffA);
            PG8_WAIT_L(8); PG8_BAR; PG8_WAIT_L(0); PG8_MMA(0, 0, At, B0); PG8_BAR; PG8_SCHED;
            PG8_LDB(B1, 0, 1); PG8_STAGE(PG8_SB(0, 0), b2, voffB);
            PG8_BAR; PG8_WAIT_L(0); PG8_MMA(0, 1, At, B1); PG8_BAR;
            PG8_LDA(At, 0, 1); PG8_STAGE(PG8_SA(0, 0), a2, voffA);
            PG8_BAR; PG8_WAIT_L(0); PG8_MMA(1, 0, At, B0); PG8_BAR; PG8_SCHED;
            PG8_STAGE(PG8_SB(0, 1), b2 + hstep, voffB);
            PG8_WAIT_V(6); PG8_BAR; PG8_MMA(1, 1, At, B1); PG8_BAR;
            PG8_LDB(B0, 1, 0); PG8_SCHED; PG8_LDA(At, 1, 0); PG8_STAGE(PG8_SA(0, 1), a2 + hstep, voffA);
            PG8_WAIT_L(8); PG8_BAR; PG8_WAIT_L(0); PG8_MMA(0, 0, At, B0); PG8_BAR; PG8_SCHED;
            PG8_LDB(B1, 1, 1); PG8_STAGE(PG8_SB(1, 0), b3, voffB);
            PG8_BAR; PG8_WAIT_L(0); PG8_MMA(0, 1, At, B1); PG8_BAR;
            PG8_LDA(At, 1, 1); PG8_STAGE(PG8_SA(1, 0), a3, voffA);
            PG8_BAR; PG8_WAIT_L(0); PG8_MMA(1, 0, At, B0); PG8_BAR; PG8_SCHED;
            PG8_STAGE(PG8_SB(1, 1), b3 + hstep, voffB);
            PG8_WAIT_V(6); PG8_BAR; PG8_MMA(1, 1, At, B1); PG8_BAR;
            }
        }
        if constexpr (ALIGN_EPI) { if (wr == 0) PG8_BAR; }
        if constexpr (!Epi::AFTER_DRAIN) { E(acc, cur, wr, wc, fr, fq); S.done(cur); }
        if (!has_next) break;
#pragma unroll
        for (int a = 0; a < 2; ++a)
#pragma unroll
            for (int b = 0; b < 2; ++b)
#pragma unroll
                for (int m = 0; m < 4; ++m)
#pragma unroll
                    for (int n = 0; n < 2; ++n) acc[a][b][m][n] = (f32x4){0.f, 0.f, 0.f, 0.f};
        cur = nxt; cA = nA; cB = nB; ++ui;
        if constexpr (ALIGN_EPI) { if (wr == 1) PG8_BAR; }
    }
    PG8_WAIT_V(0);
    if constexpr (!ALIGN_EPI) { if (wr == 0) PG8_BAR; }
    PG8_BAR;
    if constexpr (Epi::AFTER_DRAIN) { E.fused(acc, cur, wr, wc, fr, fq, lds, wid, lane); S.done(cur); }
#undef PG8_SA
#undef PG8_SB
#undef PG8_STAGE
#undef PG8_LDA
#undef PG8_LDB
#undef PG8_MMA
#undef PG8_WAIT_V
#undef PG8_WAIT_L
#undef PG8_BAR
#undef PG8_SCHED
}
}
namespace att {
#define ALAS __attribute__((address_space(3)))
typedef unsigned short bf16_t;
using bf16x8 = __attribute__((ext_vector_type(8))) short;
using s16x4 = __attribute__((ext_vector_type(4))) short;
using f32x16 = __attribute__((ext_vector_type(16))) float;
using f32x4 = __attribute__((ext_vector_type(4))) float;
using u32x4 = __attribute__((ext_vector_type(4))) unsigned;
constexpr int SEQ = 8192, DM = 1024, NHEAD = 16, NW = 8, QBLK = 32, QB = 256, KVBLK = 64, NSLOT = 3, SLOTB = 8192;
constexpr int LDS_KV = 0, LDS_WS = 3 * 32768, LDS_OST = LDS_WS + NW * 64 * 4, LDS_FC = LDS_OST,
    LDS_FLG = LDS_FC + SEQ * 4, LDS_END = LDS_FLG + 128;
static_assert(LDS_END <= 147456 - 64, "attention LDS");
__device__ __forceinline__ int crow(int r, int hi) { return (r & 3) + 8 * (r >> 2) + 4 * hi; }
__device__ __forceinline__ void glds16(const void* gsrc, unsigned lds_dst) { unsigned keep;
  asm volatile("s_mov_b32 %0, m0\n\ts_mov_b32 m0, %2\n\ts_nop 0\n\tglobal_load_lds_dwordx4 %1, off\n\ts_mov_b32 m0, %0" : "=&s"(keep) : "v"(gsrc), "s"(lds_dst) : "memory"); }
typedef float f32x2_t __attribute__((ext_vector_type(2))); typedef __bf16 bf16x2_t __attribute__((ext_vector_type(2)));
__device__ __forceinline__ unsigned cvtpk_s(float lo, float hi) { f32x2_t v = {lo, hi}; bf16x2_t b = __builtin_convertvector(v, bf16x2_t); return __builtin_bit_cast(unsigned, b); }
#define AWAIT_BAR(N) asm volatile("s_waitcnt vmcnt(" #N ") lgkmcnt(0)\n\ts_barrier" ::: "memory")
typedef ALAS const char* lds_cptr;
__device__ __forceinline__ float xhalf(float v, int hi) { auto rr = __builtin_amdgcn_permlane32_swap(__float_as_uint(v), __float_as_uint(v), false, false); return __uint_as_float(hi ? rr[0] : rr[1]); }

__device__ __forceinline__ void qkt(f32x16& p0, f32x16& p1, unsigned kq, int so, const bf16x8* qr, const f32x16& cinit) {
#pragma unroll
  for (int d0 = 0; d0 < 4; ++d0) {
    const lds_cptr ka = (lds_cptr)(uintptr_t)((kq ^ (unsigned)(d0 << 5)) + (unsigned)so);
    const bf16x8 b0 = *(const ALAS bf16x8*)(ka);
    const bf16x8 b1 = *(const ALAS bf16x8*)(ka + 4096);
    if (d0 == 0) { p0 = __builtin_amdgcn_mfma_f32_32x32x16_bf16(b0, qr[0], cinit, 0, 0, 0); p1 = __builtin_amdgcn_mfma_f32_32x32x16_bf16(b1, qr[0], cinit, 0, 0, 0); }
    else { p0 = __builtin_amdgcn_mfma_f32_32x32x16_bf16(b0, qr[d0], p0, 0, 0, 0); p1 = __builtin_amdgcn_mfma_f32_32x32x16_bf16(b1, qr[d0], p1, 0, 0, 0); } }
}
constexpr float SKIP_L2 = 151.0f;
typedef short v4i16_t __attribute__((ext_vector_type(4)));
__device__ __forceinline__ s16x4 vtr(lds_cptr p) { return __builtin_bit_cast(s16x4, __builtin_amdgcn_ds_read_tr16_b64_v4i16((ALAS v4i16_t*)p)); }
__device__ __forceinline__ void pv2(f32x16* o, lds_cptr vp, const f32x16& p0, const f32x16& p1) {
  bf16x8 pa[4];
  { u32x4 w;
    w = (u32x4){cvtpk_s(p0[0], p0[1]), cvtpk_s(p0[2], p0[3]), cvtpk_s(p0[4], p0[5]), cvtpk_s(p0[6], p0[7])}; pa[0] = __builtin_bit_cast(bf16x8, w);
    w = (u32x4){cvtpk_s(p0[8], p0[9]), cvtpk_s(p0[10], p0[11]), cvtpk_s(p0[12], p0[13]), cvtpk_s(p0[14], p0[15])}; pa[1] = __builtin_bit_cast(bf16x8, w);
    w = (u32x4){cvtpk_s(p1[0], p1[1]), cvtpk_s(p1[2], p1[3]), cvtpk_s(p1[4], p1[5]), cvtpk_s(p1[6], p1[7])}; pa[2] = __builtin_bit_cast(bf16x8, w);
    w = (u32x4){cvtpk_s(p1[8], p1[9]), cvtpk_s(p1[10], p1[11]), cvtpk_s(p1[12], p1[13]), cvtpk_s(p1[14], p1[15])}; pa[3] = __builtin_bit_cast(bf16x8, w); }
#pragma unroll
  for (int ks = 0; ks < 4; ++ks)
#pragma unroll
    for (int d0 = 0; d0 < 2; ++d0) { const s16x4 lo = vtr(vp + d0 * 4096 + ks * 1024), hh = vtr(vp + d0 * 4096 + ks * 1024 + 512);
      const bf16x8 vf = (bf16x8){lo[0], lo[1], lo[2], lo[3], hh[0], hh[1], hh[2], hh[3]};
      o[d0] = __builtin_amdgcn_mfma_f32_32x32x16_bf16(pa[ks], vf, o[d0], 0, 0, 0); }
}
template <bool BAND> __device__ __forceinline__ void sb_tile(f32x16& p0, f32x16& p1, float& R, int krel0, int hi) {
  f32x16 s0, s1;
#pragma unroll
  for (int r = 0; r < 16; ++r) {
    const float z0 = p0[r], z1 = p1[r];
    const float u0 = __builtin_amdgcn_logf(1.0f + __builtin_amdgcn_exp2f(-__builtin_fabsf(z0))), u1 = __builtin_amdgcn_logf(1.0f + __builtin_amdgcn_exp2f(-__builtin_fabsf(z1)));
    s0[r] = __builtin_fmaf(0.5f, z0 + __builtin_fabsf(z0), u0); s1[r] = __builtin_fmaf(0.5f, z1 + __builtin_fabsf(z1), u1); }
  if (BAND) {
#pragma unroll
    for (int r = 0; r < 16; ++r) { const int kr = krel0 + (r & 3) + 8 * (r >> 2); if (kr >= 0) s0[r] = 0.f; if (kr + 32 >= 0) s1[r] = 0.f; } }
#pragma unroll
  for (int g = 0; g < 4; ++g) { s0[4 * g + 2] += s0[4 * g + 3]; s0[4 * g + 1] += s0[4 * g + 2]; s0[4 * g] += s0[4 * g + 1];
                                s1[4 * g + 2] += s1[4 * g + 3]; s1[4 * g + 1] += s1[4 * g + 2]; s1[4 * g] += s1[4 * g + 1]; }
  float W[9]; W[8] = 0.f;
#pragma unroll
  for (int g = 7; g >= 0; --g) W[g] = W[g + 1] + (g < 4 ? s0[4 * g] : s1[4 * (g - 4)]);
  float base[8]; float tot0 = 0.f; const float Rold = R;
#pragma unroll
  for (int g = 0; g < 8; ++g) { auto rr = __builtin_amdgcn_permlane32_swap(__float_as_uint(W[g]), __float_as_uint(W[g + 1]), false, false);
    const float wp = __uint_as_float(hi ? rr[0] : rr[1]); base[g] = Rold + W[g + 1] + wp; if (g == 0) tot0 = W[0] + wp; }
  { const float pt = xhalf(tot0, hi); R = Rold + (hi ? pt : tot0); }
#pragma unroll
  for (int r = 0; r < 16; ++r) { p0[r] = __builtin_amdgcn_exp2f(p0[r] - (base[r >> 2] + s0[r])); p1[r] = __builtin_amdgcn_exp2f(p1[r] - (base[4 + (r >> 2)] + s1[r])); }
  if (BAND) {
#pragma unroll
    for (int r = 0; r < 16; ++r) { const int kr = krel0 + (r & 3) + 8 * (r >> 2); if (kr >= 0) p0[r] = 0.f; if (kr + 32 >= 0) p1[r] = 0.f; } }
}
template <bool BAND, bool WANT_MAX> __device__ __forceinline__ float fox_logits(f32x16& p0, f32x16& p1, const ALAS float* fc, int krel0, float c) {
#pragma unroll
  for (int g = 0; g < 4; ++g) { const f32x4 f0 = *(const ALAS f32x4*)(fc + 8 * g), f1 = *(const ALAS f32x4*)(fc + 32 + 8 * g);
#pragma unroll
    for (int e = 0; e < 4; ++e) { p0[4 * g + e] += f0[e] + c; p1[4 * g + e] += f1[e] + c; } }
  if (BAND) {
#pragma unroll
    for (int r = 0; r < 16; ++r) { const int kr = krel0 + (r & 3) + 8 * (r >> 2); if (kr > 0) p0[r] = -INFINITY; if (kr + 32 > 0) p1[r] = -INFINITY; } }
  float a = 0.f;
  if (WANT_MAX) { a = __builtin_fmaxf(p0[0], p1[0]);
#pragma unroll
    for (int r = 1; r < 16; ++r) a = __builtin_fmaxf(a, __builtin_fmaxf(p0[r], p1[r])); }
  return a;
}
__device__ __forceinline__ void kread8(bf16x8* kf, unsigned kq, int so) {
#pragma unroll
  for (int d0 = 0; d0 < 4; ++d0) { const lds_cptr ka = (lds_cptr)(uintptr_t)((kq ^ (unsigned)(d0 << 5)) + (unsigned)so); kf[2 * d0] = *(const ALAS bf16x8*)(ka); kf[2 * d0 + 1] = *(const ALAS bf16x8*)(ka + 4096); }
}
__device__ __forceinline__ void kread4(bf16x8* kf, unsigned kq, int so, int half) {
#pragma unroll
  for (int d = 0; d < 2; ++d) { const int d0 = 2 * half + d; const lds_cptr ka = (lds_cptr)(uintptr_t)((kq ^ (unsigned)(d0 << 5)) + (unsigned)so); kf[2 * d0] = *(const ALAS bf16x8*)(ka); kf[2 * d0 + 1] = *(const ALAS bf16x8*)(ka + 4096); }
}
__device__ __forceinline__ void qk8(f32x16& p0, f32x16& p1, const bf16x8* kf, const bf16x8* qr, const f32x16& cinit) {
  p0 = __builtin_amdgcn_mfma_f32_32x32x16_bf16(kf[0], qr[0], cinit, 0, 0, 0); p1 = __builtin_amdgcn_mfma_f32_32x32x16_bf16(kf[1], qr[0], cinit, 0, 0, 0);
#pragma unroll
  for (int d0 = 1; d0 < 4; ++d0) { p0 = __builtin_amdgcn_mfma_f32_32x32x16_bf16(kf[2 * d0], qr[d0], p0, 0, 0, 0); p1 = __builtin_amdgcn_mfma_f32_32x32x16_bf16(kf[2 * d0 + 1], qr[d0], p1, 0, 0, 0); }
}
__device__ __forceinline__ void vread16(bf16x8* vf, lds_cptr vp) {
#pragma unroll
  for (int ks = 0; ks < 4; ++ks)
#pragma unroll
    for (int d0 = 0; d0 < 2; ++d0) { const s16x4 lo = vtr(vp + d0 * 4096 + ks * 1024), hh = vtr(vp + d0 * 4096 + ks * 1024 + 512);
      vf[2 * ks + d0] = (bf16x8){lo[0], lo[1], lo[2], lo[3], hh[0], hh[1], hh[2], hh[3]}; }
}
__device__ __forceinline__ void vread8(bf16x8* vf, lds_cptr vp, int half) {
#pragma unroll
  for (int k2 = 0; k2 < 2; ++k2)
#pragma unroll
    for (int d0 = 0; d0 < 2; ++d0) { const int ks = 2 * half + k2; const s16x4 lo = vtr(vp + d0 * 4096 + ks * 1024), hh = vtr(vp + d0 * 4096 + ks * 1024 + 512);
      vf[2 * ks + d0] = (bf16x8){lo[0], lo[1], lo[2], lo[3], hh[0], hh[1], hh[2], hh[3]}; }
}
__device__ __forceinline__ void pack4(bf16x8* pa, const f32x16& p0, const f32x16& p1) {
  u32x4 w;
  w = (u32x4){cvtpk_s(p0[0], p0[1]), cvtpk_s(p0[2], p0[3]), cvtpk_s(p0[4], p0[5]), cvtpk_s(p0[6], p0[7])}; pa[0] = __builtin_bit_cast(bf16x8, w);
  w = (u32x4){cvtpk_s(p0[8], p0[9]), cvtpk_s(p0[10], p0[11]), cvtpk_s(p0[12], p0[13]), cvtpk_s(p0[14], p0[15])}; pa[1] = __builtin_bit_cast(bf16x8, w);
  w = (u32x4){cvtpk_s(p1[0], p1[1]), cvtpk_s(p1[2], p1[3]), cvtpk_s(p1[4], p1[5]), cvtpk_s(p1[6], p1[7])}; pa[2] = __builtin_bit_cast(bf16x8, w);
  w = (u32x4){cvtpk_s(p1[8], p1[9]), cvtpk_s(p1[10], p1[11]), cvtpk_s(p1[12], p1[13]), cvtpk_s(p1[14], p1[15])}; pa[3] = __builtin_bit_cast(bf16x8, w);
}
__device__ __forceinline__ void pv8(f32x16* o, const bf16x8* pa, const bf16x8* vf) {
#pragma unroll
  for (int ks = 0; ks < 4; ++ks)
#pragma unroll
    for (int d0 = 0; d0 < 2; ++d0) o[d0] = __builtin_amdgcn_mfma_f32_32x32x16_bf16(pa[ks], vf[2 * ks + d0], o[d0], 0, 0, 0);
}
__device__ __forceinline__ void fox_init(f32x16& p0, f32x16& p1, const ALAS float* fc, float c) {
#pragma unroll
  for (int g = 0; g < 4; ++g) { const f32x4 f0 = *(const ALAS f32x4*)(fc + 8 * g), f1 = *(const ALAS f32x4*)(fc + 32 + 8 * g);
#pragma unroll
    for (int e = 0; e < 4; ++e) { p0[4 * g + e] = c + f0[e]; p1[4 * g + e] = c + f1[e]; } }
}
__device__ __forceinline__ void fox_init0(f32x16& p0, f32x16& p1, const ALAS float* fc) {
#pragma unroll
  for (int g = 0; g < 4; ++g) { const f32x4 f0 = *(const ALAS f32x4*)(fc + 8 * g), f1 = *(const ALAS f32x4*)(fc + 32 + 8 * g);
#pragma unroll
    for (int e = 0; e < 4; ++e) { p0[4 * g + e] = f0[e]; p1[4 * g + e] = f1[e]; } }
}
__device__ __forceinline__ void qk8acc(f32x16& p0, f32x16& p1, const bf16x8* kf, const bf16x8* qr) {
#pragma unroll
  for (int d0 = 0; d0 < 4; ++d0) { p0 = __builtin_amdgcn_mfma_f32_32x32x16_bf16(kf[2 * d0], qr[d0], p0, 0, 0, 0); p1 = __builtin_amdgcn_mfma_f32_32x32x16_bf16(kf[2 * d0 + 1], qr[d0], p1, 0, 0, 0); }
}
#define SBAR0() __builtin_amdgcn_sched_barrier(0)
#define SGB_PATTERN(NM, ND, NV) do { _Pragma("unroll") for (int g_ = 0; g_ < (NM); ++g_) { __builtin_amdgcn_sched_group_barrier(0x008, 1, 0); if ((ND) > 0) __builtin_amdgcn_sched_group_barrier(0x100, (ND), 0); if ((NV) > 0) __builtin_amdgcn_sched_group_barrier(0x002, (NV), 0); } } while (0)
template <int MODE> __device__ __forceinline__ void attn_unit(int b, int h, int qb, const bf16_t* Q, const bf16_t* __restrict__ K, const bf16_t* __restrict__ V, bf16_t* O, const float* FC2, const float* kgain, ALAS char* shm) {
  int tid = threadIdx.x; asm volatile("" : "+v"(tid));
  const int lane = tid & 63, r32 = lane & 31, hi = lane >> 5; const int wid = __builtin_amdgcn_readfirstlane(tid >> 6);
  const long rowbase = (long)b * SEQ; const int q0 = qb * QB;
  const bf16_t* Qw = Q + (rowbase + q0 + wid * QBLK) * DM + h * 64;
  const bf16_t *Kh = K + rowbase * DM + h * 64, *Vh = V + rowbase * DM + h * 64;
  const unsigned lds0 = (unsigned)(uintptr_t)shm;
  ALAS float* wsf = (ALAS float*)(shm + LDS_WS) + wid * 64;
  const bf16_t* ksrc = Kh + (long)(8 * wid + (lane >> 3)) * DM + (((lane & 7) ^ ((lane >> 3) & 7)) * 8);
  const bf16_t* vsrc = Vh + (long)(16 * (wid & 3) + (lane >> 2)) * DM + (wid >> 2) * 32 + (lane & 3) * 8;
  const unsigned pdst = lds0 + LDS_KV + wid * 1024;
#define DMA_PAIR(tA, sb) do { glds16(ksrc + (long)(tA) * KVBLK * DM, (unsigned)__builtin_amdgcn_readfirstlane(pdst + (sb))); glds16(ksrc + (long)((tA) - 1) * KVBLK * DM, (unsigned)__builtin_amdgcn_readfirstlane(pdst + (sb) + 8192)); \
    glds16(vsrc + (long)(tA) * KVBLK * DM, (unsigned)__builtin_amdgcn_readfirstlane(pdst + (sb) + 16384)); glds16(vsrc + (long)((tA) - 1) * KVBLK * DM, (unsigned)__builtin_amdgcn_readfirstlane(pdst + (sb) + 24576)); } while (0)
  const unsigned kq = (unsigned)(uintptr_t)((lds_cptr)shm + LDS_KV) + r32 * 128 + ((hi ^ (r32 & 7)) << 4);
  const lds_cptr vp0 = (lds_cptr)shm + LDS_KV + 16384 + ((lane >> 4) & 1) * 32 + (lane & 3) * 8 + (4 * hi + ((lane & 15) >> 2)) * 64;
  const int NT = (q0 + QB) / KVBLK, NS = NT / 2;
  DMA_PAIR(NT - 1, 0); DMA_PAIR(NT - 3, 32768);
  bf16x8 qr[4];
#pragma unroll
  for (int d0 = 0; d0 < 4; ++d0) qr[d0] = *reinterpret_cast<const bf16x8*>(&Qw[(long)r32 * DM + d0 * 16 + hi * 8]);
  const int qrel = wid * QBLK + r32;
  float fq2 = 0.f; bool fast = false;
  if (MODE == 1) {
    const float* fsrc = FC2 + ((long)b * NHEAD + h) * SEQ; ALAS float* fc = (ALAS float*)(shm + LDS_FC);
    f32x4 fv[4];
#pragma unroll
    for (int j = 0; j < 4; ++j) { const int i = tid * 4 + j * 2048; if (i < q0 + QB) fv[j] = *(const f32x4*)(fsrc + i); }
    const float fref = fsrc[q0 + 128];
#pragma unroll
    for (int j = 0; j < 4; ++j) { const int i = tid * 4 + j * 2048; if (i < q0 + QB) *(ALAS f32x4*)(fc + i) = fref - fv[j]; }
    fq2 = fsrc[q0 + qrel] - fref;
    fast = __builtin_amdgcn_readfirstlane((fsrc[q0] - fsrc[q0 + QB - 1]) <= 50.0f ? 1 : 0) != 0;
  }
  f32x16 o[2]; o[0] = f32x16{}; o[1] = f32x16{};
  float R = 0.f;
  float mhat = 0.f;
  float zb = 0.f;
  if (MODE == 1) {
    float ss = 0.f;
#pragma unroll
    for (int d0 = 0; d0 < 4; ++d0)
#pragma unroll
      for (int e = 0; e < 8; ++e) { const float qv = __uint_as_float(((unsigned)(unsigned short)qr[d0][e]) << 16); ss += qv * qv; }
    ss += xhalf(ss, hi);
    float gm = __builtin_fabsf(kgain[lane]);
#pragma unroll
    for (int o_ = 1; o_ < 64; o_ <<= 1) gm = __builtin_fmaxf(gm, __shfl_xor(gm, o_));
    zb = sqrtf(ss) * gm * 8.0f * 1.01f;
  }
  ALAS unsigned* flg = (ALAS unsigned*)(shm + LDS_FLG);
  const int i_first = (wid < 4) ? 1 : 0;
  const f32x16 zc = f32x16{};
#define STEP_BODY(BANDV) do { \
      const int tA = NT - 1 - 2 * si; const int krA = tA * KVBLK - q0 + 4 * hi - qrel, krB = krA - KVBLK; \
      const lds_cptr vpA = vp0 + sbl, vpB = vp0 + sbl + 8192; \
      f32x16 pA0, pA1, pB0, pB1; \
      const bool skipA = (MODE == 0) && BANDV && (tA * KVBLK - q0 >= 32 * wid + 31);     \
      if (MODE == 0) { \
        if (!skipA) qkt(pA0, pA1, kq, sbl, qr, zc); \
        qkt(pB0, pB1, kq, sbl + 8192, qr, zc); \
        if (!skipA) sb_tile<BANDV>(pA0, pA1, R, krA, hi); \
        sb_tile<BANDV>(pB0, pB1, R, krB, hi); \
      } else { \
        const float c_ = fast ? 0.f : (si == i_first ? fq2 : fq2 - mhat); const f32x16 z0_ = f32x16{}; \
        qkt(pA0, pA1, kq, sbl, qr, z0_); qkt(pB0, pB1, kq, sbl + 8192, qr, z0_); \
        const ALAS float* fc = (const ALAS float*)(shm + LDS_FC) + tA * KVBLK + 4 * hi; \
        if (BANDV && si == i_first) {         \
          float rm = __builtin_fmaxf(fox_logits<true, true>(pA0, pA1, fc, krA, c_), fox_logits<true, true>(pB0, pB1, fc - KVBLK, krB, c_)); \
          rm = __builtin_fmaxf(rm, xhalf(rm, hi)); mhat = rm; const float sub_ = fast ? 0.f : rm; \
          _Pragma("unroll") for (int r = 0; r < 16; ++r) { pA0[r] -= sub_; pA1[r] -= sub_; pB0[r] -= sub_; pB1[r] -= sub_; } \
        } else { (void)fox_logits<BANDV, false>(pA0, pA1, fc, krA, c_); (void)fox_logits<BANDV, false>(pB0, pB1, fc - KVBLK, krB, c_); } \
        float sacc = 0.f; \
        _Pragma("unroll") for (int r = 0; r < 16; ++r) { pA0[r] = __builtin_amdgcn_exp2f(pA0[r]); pA1[r] = __builtin_amdgcn_exp2f(pA1[r]); pB0[r] = __builtin_amdgcn_exp2f(pB0[r]); pB1[r] = __builtin_amdgcn_exp2f(pB1[r]); \
          sacc += (pA0[r] + pA1[r]) + (pB0[r] + pB1[r]); } \
        R += sacc; \
      } \
      if (!skipA) pv2(o, vpA, pA0, pA1); \
      pv2(o, vpB, pB0, pB1); \
    } while (0)
#define STEP_PIPE(FASTV) do { \
      const int tA = NT - 1 - 2 * si; \
      const lds_cptr vpA = vp0 + sbl, vpB = vp0 + sbl + 8192; \
      f32x16 pA0, pA1, pB0, pB1; bf16x8 kfa[8], kfb[8], vfa[8], vfb[8], paA[4], paB[4]; \
      if (MODE == 0) { \
        SBAR0(); kread8(kfa, kq, sbl); SBAR0(); \
        qk8(pA0, pA1, kfa, qr, zc); kread8(kfb, kq, sbl + 8192); SGB_PATTERN(8, 1, 0); SBAR0(); \
        qk8(pB0, pB1, kfb, qr, zc); sb_tile<false>(pA0, pA1, R, 0, hi); pack4(paA, pA0, pA1); SGB_PATTERN(8, 0, 58); SBAR0(); \
        vread16(vfa, vpA); __builtin_amdgcn_sched_group_barrier(0x100, 16, 0); \
        pv8(o, paA, vfa); sb_tile<false>(pB0, pB1, R, 0, hi); pack4(paB, pB0, pB1); SGB_PATTERN(8, 0, 58); SBAR0(); \
        vread16(vfb, vpB); pv8(o, paB, vfb); SBAR0(); \
      } else { \
        const ALAS float* fc = (const ALAS float*)(shm + LDS_FC) + tA * KVBLK + 4 * hi; const float c = fq2 - mhat; \
        SBAR0(); kread8(kfa, kq, sbl); if (FASTV) fox_init0(pA0, pA1, fc); else fox_init(pA0, pA1, fc, c); SBAR0(); \
        qk8acc(pA0, pA1, kfa, qr); if (!FASTV) { fox_init(pB0, pB1, fc - KVBLK, c); SGB_PATTERN(8, 1, 8); } SBAR0(); \
        kread8(kfb, kq, sbl + 8192); if (FASTV) fox_init0(pB0, pB1, fc - KVBLK); qk8acc(pB0, pB1, kfb, qr); { float sa = 0.f; \
          _Pragma("unroll") for (int r = 0; r < 16; ++r) { pA0[r] = __builtin_amdgcn_exp2f(pA0[r]); pA1[r] = __builtin_amdgcn_exp2f(pA1[r]); sa += pA0[r] + pA1[r]; } R += sa; } \
        pack4(paA, pA0, pA1); SGB_PATTERN(8, 0, 11); SBAR0(); \
        vread16(vfa, vpA); __builtin_amdgcn_sched_group_barrier(0x100, 16, 0); pv8(o, paA, vfa); { float sa = 0.f; \
          _Pragma("unroll") for (int r = 0; r < 16; ++r) { pB0[r] = __builtin_amdgcn_exp2f(pB0[r]); pB1[r] = __builtin_amdgcn_exp2f(pB1[r]); sa += pB0[r] + pB1[r]; } R += sa; } \
        pack4(paB, pB0, pB1); SGB_PATTERN(8, 0, 11); SBAR0(); \
        vread16(vfb, vpB); pv8(o, paB, vfb); SBAR0(); \
      } \
    } while (0)
  int sb = 0, sb2 = 65536; bool wdone = false;
  const int lead = (wid < 4) ? 1 : 0;
  if (wid >= 4) __builtin_amdgcn_s_setprio(2);
  for (int i = 0; i < NS; ++i) {
    AWAIT_BAR(0);
    if (i > 0) {
      const u32x4 fa = *(const ALAS u32x4*)(flg + 8 * ((i - 1) & 1)), fb = *(const ALAS u32x4*)(flg + 8 * ((i - 1) & 1) + 4);
      if (((fa.x & fa.y) & (fa.z & fa.w) & (fb.x & fb.y) & (fb.z & fb.w)) != 0u) break;
    }
    if (i + 2 < NS) DMA_PAIR(NT - 5 - 2 * i, sb2);
    const int si = i + lead; const int sbl = lead ? ((sb == 65536) ? 0 : sb + 32768) : sb;
    if (si < NS && !wdone) { if (si < 2) STEP_BODY(true); else if (MODE == 1 && fast) STEP_PIPE(true); else if (MODE == 1) STEP_BODY(false); else STEP_PIPE(false);     }
    { bool done_ = wdone || (si + 1 >= NS);
      if (!done_) {
        if (MODE == 0) done_ = __all(R > SKIP_L2);
        else { const float fe = *((const ALAS float*)(shm + LDS_FC) + (NT - 2 - 2 * si) * KVBLK - 1);
               done_ = __all(zb + fe + (fast ? 0.f : fq2) - mhat < -SKIP_L2); } }
      wdone = done_;
      if (lane == 0) flg[8 * (i & 1) + wid] = done_ ? 1u : 0u; }
    sb = (sb == 65536) ? 0 : sb + 32768; sb2 = (sb2 == 65536) ? 0 : sb2 + 32768;
  }
#undef STEP_BODY
#undef STEP_PIPE
  __builtin_amdgcn_s_setprio(0);
  AWAIT_BAR(0);
  int tid2 = tid; asm volatile("" : "+v"(tid2));
  const int lane2 = tid2 & 63, r32b = lane2 & 31, hib = lane2 >> 5;
  ALAS float* wsf2 = (ALAS float*)(shm + LDS_WS) + wid * 64;
  float rli[16];
  if (MODE == 1) {
    const float l = R + xhalf(R, hib);
    if (hib == 0) wsf2[32 + r32b] = l;
#pragma unroll
    for (int r = 0; r < 16; ++r) rli[r] = __builtin_amdgcn_rcpf(wsf2[32 + crow(r, hib)]);
  } else {
#pragma unroll
    for (int r = 0; r < 16; ++r) rli[r] = 1.f;
  }
  bf16_t* Ow = O + (rowbase + q0 + wid * QBLK) * DM + h * 64;
  { ALAS bf16_t* stg = (ALAS bf16_t*)(shm + LDS_OST) + wid * 2048;
#pragma unroll
    for (int r = 0; r < 16; ++r) { const int orow = crow(r, hib);
#pragma unroll
      for (int d0 = 0; d0 < 2; ++d0) { const unsigned pk = cvtpk_s(o[d0][r] * rli[r], 0.f); stg[orow * 64 + d0 * 32 + r32b] = (bf16_t)(pk & 0xffffu); } }
    asm volatile("s_waitcnt lgkmcnt(0)" ::: "memory");
#pragma unroll
    for (int i = 0; i < 4; ++i) { const int row = i * 8 + (lane2 >> 3), ch = lane2 & 7; const u32x4 v = *(const ALAS u32x4*)(stg + row * 64 + ch * 8); *(u32x4*)(Ow + (long)row * DM + ch * 8) = v; } }
  asm volatile("s_waitcnt lgkmcnt(0)\n\ts_barrier" ::: "memory");
#undef DMA_PAIR
}
template <int MODE> __device__ __forceinline__ void attn_phase(ALAS char* lds, const bf16_t* Q, const bf16_t* K, const bf16_t* V, bf16_t* O, const float* FC2, const float* kgain, unsigned* ctr) {
  ALAS unsigned* qw = (ALAS unsigned*)(lds + LDS_FLG) + 16;
  for (;;) {
    if (threadIdx.x == 0) *qw = __hip_atomic_fetch_add(ctr, 1u, __ATOMIC_RELAXED, __HIP_MEMORY_SCOPE_AGENT);
    __syncthreads();
    const unsigned u = *qw;
    if (u >= 1024u) break;
    const int qb = 31 - (int)(u >> 5), bh = (int)(u & 31u);
    attn_unit<MODE>(bh / NHEAD, bh % NHEAD, qb, Q, K, V, O, FC2, kgain, lds);
  }
}
template <bool BAND> __device__ __forceinline__ void sb_half(f32x16& p, float& R, int krel0, int hi) {
  f32x16 s;
#pragma unroll
  for (int r = 0; r < 16; ++r) { const float z = p[r]; const float u = __builtin_amdgcn_logf(1.0f + __builtin_amdgcn_exp2f(-__builtin_fabsf(z))); s[r] = __builtin_fmaf(0.5f, z + __builtin_fabsf(z), u); }
  if (BAND) {
#pragma unroll
    for (int r = 0; r < 16; ++r) { const int kr = krel0 + (r & 3) + 8 * (r >> 2); if (kr >= 0) s[r] = 0.f; } }
#pragma unroll
  for (int g = 0; g < 4; ++g) { s[4 * g + 2] += s[4 * g + 3]; s[4 * g + 1] += s[4 * g + 2]; s[4 * g] += s[4 * g + 1]; }
  float W[5]; W[4] = 0.f;
#pragma unroll
  for (int g = 3; g >= 0; --g) W[g] = W[g + 1] + s[4 * g];
  float base[4]; float tot0 = 0.f; const float Rold = R;
#pragma unroll
  for (int g = 0; g < 4; ++g) { auto rr = __builtin_amdgcn_permlane32_swap(__float_as_uint(W[g]), __float_as_uint(W[g + 1]), false, false);
    const float wp = __uint_as_float(hi ? rr[0] : rr[1]); base[g] = Rold + W[g + 1] + wp; if (g == 0) tot0 = W[0] + wp; }
  { const float pt = xhalf(tot0, hi); R = Rold + (hi ? pt : tot0); }
#pragma unroll
  for (int r = 0; r < 16; ++r) p[r] = __builtin_amdgcn_exp2f(p[r] - (base[r >> 2] + s[r]));
  if (BAND) {
#pragma unroll
    for (int r = 0; r < 16; ++r) { const int kr = krel0 + (r & 3) + 8 * (r >> 2); if (kr >= 0) p[r] = 0.f; } }
}
__device__ __forceinline__ void sb_wave_unit(int b, int h, int rb, const bf16_t* Q, const bf16_t* __restrict__ K, const bf16_t* __restrict__ V, bf16_t* O, ALAS char* wl) {
  int tid = threadIdx.x; asm volatile("" : "+v"(tid));
  const int lane = tid & 63, r32 = lane & 31, hi = lane >> 5;
  const long rowbase = (long)b * SEQ; const int r0 = rb * QBLK;
  const bf16_t* Qw = Q + (rowbase + r0) * DM + h * 64;
  const bf16_t *Kh = K + rowbase * DM + h * 64, *Vh = V + rowbase * DM + h * 64;
  const unsigned l0 = (unsigned)(uintptr_t)wl;
  const bf16_t* ksrc = Kh + (long)(lane >> 3) * DM + (((lane & 7) ^ ((lane >> 3) & 7)) * 8);
  const bf16_t* vsrc = Vh + (long)(lane >> 2) * DM + (lane & 3) * 8;
  const unsigned kq = l0 + r32 * 128 + ((hi ^ (r32 & 7)) << 4);
  const lds_cptr vp = (lds_cptr)wl + 8192 + ((lane >> 4) & 1) * 32 + (lane & 3) * 8 + (4 * hi + ((lane & 15) >> 2)) * 64;
  bf16x8 qr[4];
#pragma unroll
  for (int d0 = 0; d0 < 4; ++d0) qr[d0] = *reinterpret_cast<const bf16x8*>(&Qw[(long)r32 * DM + d0 * 16 + hi * 8]);
  f32x16 o[2]; o[0] = f32x16{}; o[1] = f32x16{}; float R = 0.f; const f32x16 zc = f32x16{};
  const int tdiag = (r0 + QBLK - 1) >> 6;
  for (int t = tdiag; t >= 0; --t) {
#pragma unroll
    for (int j = 0; j < 8; ++j) glds16(ksrc + (long)(64 * t + 8 * j) * DM, (unsigned)__builtin_amdgcn_readfirstlane(l0 + j * 1024));
#pragma unroll
    for (int p = 0; p < 8; ++p) glds16(vsrc + (long)(64 * t + 16 * (p & 3)) * DM + 32 * (p >> 2), (unsigned)__builtin_amdgcn_readfirstlane(l0 + 8192 + p * 1024));
    asm volatile("s_waitcnt vmcnt(0)" ::: "memory");
    f32x16 p0, p1; bf16x8 kf[8], vf[8], pa[4];
    kread8(kf, kq, 0); SBAR0(); qk8(p0, p1, kf, qr, zc);
    vread16(vf, vp); SBAR0();
    bool stop = false;
    if (t == tdiag) {
      if ((r0 & 32) == 0) { p1 = f32x16{}; sb_half<true>(p0, R, 64 * t - r0 + 4 * hi - r32, hi); }
      else { sb_half<true>(p1, R, 64 * t + 32 - r0 + 4 * hi - r32, hi); sb_half<false>(p0, R, 0, hi); }
    } else {
      sb_half<false>(p1, R, 0, hi);
      if (__all(R > SKIP_L2)) { p0 = f32x16{}; stop = true; } else sb_half<false>(p0, R, 0, hi);
    }
    pack4(pa, p0, p1); pv8(o, pa, vf);
    asm volatile("s_waitcnt lgkmcnt(0)" ::: "memory");
    if (stop || __all(R > SKIP_L2)) break;
  }
  { ALAS bf16_t* stg = (ALAS bf16_t*)wl;
#pragma unroll
    for (int r = 0; r < 16; ++r) { const int orow = crow(r, hi);
#pragma unroll
      for (int d0 = 0; d0 < 2; ++d0) { const unsigned pk = cvtpk_s(o[d0][r], 0.f); stg[orow * 64 + d0 * 32 + r32] = (bf16_t)(pk & 0xffffu); } }
    asm volatile("s_waitcnt lgkmcnt(0)" ::: "memory");
    bf16_t* Ow = O + (rowbase + r0) * DM + h * 64;
#pragma unroll
    for (int i = 0; i < 4; ++i) { const int row = i * 8 + (lane >> 3), ch = lane & 7; const u32x4 v = *(const ALAS u32x4*)(stg + row * 64 + ch * 8); *(u32x4*)(Ow + (long)row * DM + ch * 8) = v; }
    asm volatile("s_waitcnt lgkmcnt(0)" ::: "memory"); }
}
__device__ __forceinline__ void sb_wave_phase(ALAS char* lds, const bf16_t* Q, const bf16_t* K, const bf16_t* V, bf16_t* O, int G, int bx) {
  const int wid = __builtin_amdgcn_readfirstlane(threadIdx.x >> 6); ALAS char* wl = lds + wid * 16384;
  const int NWV = G * NW;
  for (int wu = bx * NW + wid; wu < 32 * 256 * 4 / 4 * 4 / 4; wu += NWV) {
    const int g = wu % 2048, j = wu / 2048; const int blk = g >> 3, wv = g & 7; const int bh = (blk & 7) + 8 * j, rb = (blk >> 3) * 8 + wv;
    sb_wave_unit(bh / NHEAD, bh % NHEAD, rb, Q, K, V, O, wl);
  }
}
}
constexpr int NWAVES = 8;
constexpr int BATCH = 2, T = 8192, D = 1024, H = 16, HD = 64, FF = 2816, M = BATCH * T;
constexpr float RMS_EPS = 1e-6f;
constexpr float LOG2E = 1.4426950408889634f;
constexpr float QSCALE = 0.125f * LOG2E;
#ifndef MK_PER_PHASE
#define MK_PER_PHASE 0
#endif
constexpr int N_PHASES = 15;
constexpr size_t MiB = 1u << 20;
constexpr size_t WS_CTL = 0;
constexpr size_t WS_MOD = 1 * MiB;
constexpr size_t WS_LOGF = 2 * MiB;
constexpr size_t WS_FC = 3 * MiB;
constexpr size_t WS_PART = 65536;
constexpr size_t WS_BIAS2 = 217 * MiB;
constexpr size_t WS_WQKV = 4 * MiB, WS_WO0 = 10 * MiB, WS_WIN0 = 12 * MiB, WS_WDN0 = 23 * MiB, WS_WKV = 29 * MiB, WS_WQ1 = 33 * MiB, WS_WO1 = 35 * MiB, WS_WIN1 = 37 * MiB, WS_WDN1 = 48 * MiB;
constexpr size_t WS_HA = 56 * MiB, WS_HQ = 88 * MiB;
constexpr size_t WS_Q = 120 * MiB, WS_K = 152 * MiB, WS_V = 184 * MiB;
constexpr size_t WS_ACT = 120 * MiB;
constexpr size_t WS_END = 218 * MiB;
static_assert(WS_WDN1 + (size_t)D * FF * 2 <= WS_HA && WS_ACT + (size_t)M * FF * 2 <= WS_BIAS2 && WS_WQ1 == WS_WKV + (size_t)2048 * D * 2 && WS_HQ == WS_HA + (size_t)M * D * 2, "d_ws map");
constexpr int RING_BYTES = 131072, LDS_BYTES = 147456;

#define LAS __attribute__((address_space(3)))
typedef unsigned short bf16;
typedef unsigned v4u __attribute__((ext_vector_type(4)));
typedef float f32x4 __attribute__((ext_vector_type(4)));
#define LDS_WAIT() asm volatile("s_waitcnt lgkmcnt(0)" ::: "memory")
__device__ __forceinline__ unsigned f2bf(float f) { unsigned u = __builtin_bit_cast(unsigned, f); return (u + 0x7fffu + ((u >> 16) & 1u)) >> 16; }
__device__ __forceinline__ unsigned pk2(float lo, float hi) { return f2bf(lo) | (f2bf(hi) << 16); }
__device__ __forceinline__ float wave_sum(float v) {
#pragma unroll
    for (int o = 1; o < 64; o <<= 1) v += __shfl_xor(v, o);
    return v;
}
struct Args { const float* in[19]; float* out; unsigned char* ws; int ph_lo, ph_hi; };

__device__ __forceinline__ void transpose_item(const float* W, int ldw, bf16* WT, int Kd, int drow0, int k0, int n0, LAS float* scr, int lane) {
    float tv[32];
#pragma unroll
    for (int i = 0; i < 32; ++i) { const int kk = 2 * i + (lane >> 5); tv[i] = W[(size_t)(k0 + kk) * ldw + n0 + (lane & 31)]; }
#pragma unroll
    for (int i = 0; i < 32; ++i) { const int kk = 2 * i + (lane >> 5); scr[kk * 33 + (lane & 31)] = tv[i]; }
    LDS_WAIT(); asm volatile("" ::: "memory");
    const int c = lane & 7;
#pragma unroll
    for (int j = 0; j < 4; ++j) { const int n = (lane >> 3) + 8 * j; const LAS float* s = scr + (8 * c) * 33 + n;
        v4u o; o.x = pk2(s[0 * 33], s[1 * 33]); o.y = pk2(s[2 * 33], s[3 * 33]); o.z = pk2(s[4 * 33], s[5 * 33]); o.w = pk2(s[6 * 33], s[7 * 33]);
        *(v4u*)(WT + (size_t)(drow0 + n) * Kd + k0 + 8 * c) = o; }
    LDS_WAIT(); asm volatile("" ::: "memory");
}
__device__ __forceinline__ int row_map(int kind, int n0) {
    if (kind == 1) { const int up = n0 >= FF; const int j = up ? n0 - FF : n0; return 256 * (j >> 7) + (up ? 128 : 0) + (j & 127); }
    if (kind == 2 && n0 < 1024) { const int p = n0 >> 8, w = (n0 >> 6) & 3, jj = (n0 >> 5) & 1; return 256 * p + 128 * jj + 32 * w; }
    return n0;
}
__device__ __forceinline__ void transpose_weights(const Args& a, LAS unsigned char* lds, int lane, int w, int nw, int mat_lo, int mat_hi) {
    LAS float* scr = (LAS float*)(lds + (threadIdx.x >> 6) * 16384);
    for (int it = w; ; it += nw) {
        int r = it, mi = mat_lo; const float* W = nullptr; int ldw = 0, ncb = 0, Kd = 0, kind = 0; bf16* WT = nullptr;
        for (; mi < mat_hi; ++mi) {
            switch (mi) {
                case 0: W = a.in[8]; ldw = 3 * D; ncb = 96; Kd = D; kind = 0; WT = (bf16*)(a.ws + WS_WQKV); break;
                case 1: W = a.in[9]; ldw = D; ncb = 32; Kd = D; kind = 0; WT = (bf16*)(a.ws + WS_WO0); break;
                case 2: W = a.in[6]; ldw = 2 * FF; ncb = 176; Kd = D; kind = 1; WT = (bf16*)(a.ws + WS_WIN0); break;
                case 3: W = a.in[7]; ldw = D; ncb = 32; Kd = FF; kind = 0; WT = (bf16*)(a.ws + WS_WDN0); break;
                case 4: W = a.in[13]; ldw = 2 * D + H; ncb = 64; Kd = D; kind = 2; WT = (bf16*)(a.ws + WS_WKV); break;
                case 5: W = a.in[16]; ldw = D; ncb = 32; Kd = D; kind = 2; WT = (bf16*)(a.ws + WS_WQ1); break;
                case 6: W = a.in[18]; ldw = D; ncb = 32; Kd = D; kind = 0; WT = (bf16*)(a.ws + WS_WO1); break;
                case 7: W = a.in[6] + (size_t)D * 2 * FF; ldw = 2 * FF; ncb = 176; Kd = D; kind = 1; WT = (bf16*)(a.ws + WS_WIN1); break;
                default: W = a.in[7] + (size_t)FF * D; ldw = D; ncb = 32; Kd = FF; kind = 0; WT = (bf16*)(a.ws + WS_WDN1); break;
            }
            const int items = (Kd / 64) * ncb; if (r < items) break; r -= items;
        }
        if (mi >= mat_hi) break;
        const int kb = r / ncb, nb = r % ncb;
        transpose_item(W, ldw, WT, Kd, row_map(kind, 32 * nb), 64 * kb, 32 * nb, scr, lane);
    }
}
__device__ __forceinline__ void prologue(const Args& a, LAS unsigned char* lds, int tid, int lane, int wave, int G) {
    const int bx = blockIdx.x;
    float* mod = (float*)(a.ws + WS_MOD);
    if (bx < 224) {
        LAS float* ca = (LAS float*)lds; LAS float* red = (LAS float*)(lds + 8192);
        for (int i = tid; i < 2 * D; i += 512) { const float v = a.in[1][i]; ca[i] = v / (1.f + __expf(-v)); }
        __syncthreads();
        const float* W; int N, col0; const float* bias; float* dst; int dstride;
        if (bx < 96) { W = a.in[2]; N = 6 * D; col0 = 64 * bx; bias = a.in[3] + col0; dst = mod + col0; dstride = 6 * D; }
        else if (bx < 192) { W = a.in[2] + (size_t)D * 6 * D; N = 6 * D; col0 = 64 * (bx - 96); bias = a.in[3] + 6 * D + col0; dst = mod + 2 * 6 * D + col0; dstride = 6 * D; }
        else { W = a.in[10]; N = 2 * D; col0 = 64 * (bx - 192); bias = a.in[11] + col0; dst = mod + 4 * 6 * D + col0; dstride = 2 * D; }
        const int rg = lane >> 4, cq = lane & 15; f32x4 a0 = {0.f, 0.f, 0.f, 0.f}, a1 = {0.f, 0.f, 0.f, 0.f}; const float* wp = W + (size_t)(128 * wave + rg) * N + col0 + 4 * cq;
#pragma unroll
        for (int h2 = 0; h2 < 2; ++h2) { f32x4 wv[16];
#pragma unroll
            for (int k = 0; k < 16; ++k) wv[k] = *(const f32x4*)(wp + (size_t)(4 * (16 * h2 + k)) * N);
#pragma unroll
            for (int k = 0; k < 16; ++k) { const int kr = 128 * wave + 4 * (16 * h2 + k) + rg; a0 += wv[k] * ca[kr]; a1 += wv[k] * ca[D + kr]; } }
#pragma unroll
        for (int e = 0; e < 4; ++e) { a0[e] += __shfl_xor(a0[e], 16); a0[e] += __shfl_xor(a0[e], 32); a1[e] += __shfl_xor(a1[e], 16); a1[e] += __shfl_xor(a1[e], 32); }
        if (rg == 0) { *(LAS f32x4*)(red + (wave * 2 + 0) * 64 + 4 * cq) = a0; *(LAS f32x4*)(red + (wave * 2 + 1) * 64 + 4 * cq) = a1; }
        __syncthreads();
        if (tid < 128) { const int b = tid >> 6, c = tid & 63; float s = 0.f;
#pragma unroll
            for (int w = 0; w < 8; ++w) s += red[(w * 2 + b) * 64 + c];
            dst[(size_t)b * dstride + c] = s + bias[c]; }
        __syncthreads();
    }
    transpose_weights(a, lds, lane, bx * NWAVES + wave, G * NWAVES, 0, 4);
}
__device__ __forceinline__ void norm_phase(const float* x, bf16* out, const float* g, const float* shift, const float* scale, int bstride, int gw, int NGW, int lane) {
    constexpr int NR = 4; f32x4 ca[4], cs[4]; int curb = -1;
    for (int m0 = gw; m0 < M; m0 += NR * NGW) {
        f32x4 v[NR][4]; float s[NR];
#pragma unroll
        for (int r = 0; r < NR; ++r) { const int m = m0 + r * NGW; if (m < M) { const f32x4* xr = (const f32x4*)(x + (size_t)m * D) + lane;
#pragma unroll
            for (int j = 0; j < 4; ++j) v[r][j] = xr[64 * j]; } }
#pragma unroll
        for (int r = 0; r < NR; ++r) { s[r] = 0.f; if (m0 + r * NGW < M) {
#pragma unroll
            for (int j = 0; j < 4; ++j) s[r] += (v[r][j].x * v[r][j].x + v[r][j].y * v[r][j].y) + (v[r][j].z * v[r][j].z + v[r][j].w * v[r][j].w); } }
#pragma unroll
        for (int o = 1; o < 64; o <<= 1)
#pragma unroll
            for (int r = 0; r < NR; ++r) s[r] += __shfl_xor(s[r], o);
#pragma unroll
        for (int r = 0; r < NR; ++r) { const int m = m0 + r * NGW; if (m < M) {
            const int b = m >> 13;
            if (b != curb) { curb = b;
#pragma unroll
                for (int j = 0; j < 4; ++j) { const int c = 256 * j + 4 * lane; ca[j] = *(const f32x4*)(g + c) * (1.0f + *(const f32x4*)(scale + (size_t)b * bstride + c)); cs[j] = *(const f32x4*)(shift + (size_t)b * bstride + c); } }
            const float rstd = 1.0f / sqrtf(s[r] * (1.f / D) + RMS_EPS);
            unsigned long long* o8 = (unsigned long long*)(out + (size_t)m * D) + lane;
#pragma unroll
            for (int j = 0; j < 4; ++j) { const f32x4 y = v[r][j] * rstd * ca[j] + cs[j]; o8[64 * j] = (unsigned long long)pk2(y.x, y.y) | ((unsigned long long)pk2(y.z, y.w) << 32); } } }
    }
}
__device__ __forceinline__ void bias2_phase(unsigned char* ws, int gw, int NGW, int lane, int layer) {
    const float* mod = (const float*)(ws + WS_MOD); float* b2 = (float*)(ws + WS_BIAS2);
    constexpr int NB = 6; v4u w0[NB], w1[NB];
    for (int it0 = gw + layer * 5632; it0 < (layer + 1) * 5632; it0 += NB * NGW) {
#pragma unroll
        for (int j = 0; j < NB; ++j) { const int it = it0 + j * NGW; if (it < (layer + 1) * 5632) { const int l = it / 5632, rho = it % 5632; const bf16* wrow = (const bf16*)(ws + (l ? WS_WIN1 : WS_WIN0)) + (size_t)rho * D + 16 * lane;
            w0[j] = *(const v4u*)wrow; w1[j] = *(const v4u*)(wrow + 8); } }
#pragma unroll
        for (int j = 0; j < NB; ++j) { const int it = it0 + j * NGW; if (it < (layer + 1) * 5632) { const int l = it / 5632, rho = it % 5632;
            const unsigned wu[8] = {w0[j].x, w0[j].y, w0[j].z, w0[j].w, w1[j].x, w1[j].y, w1[j].z, w1[j].w};
            float a0 = 0.f, a1 = 0.f; const float* s0 = mod + (size_t)(l * 2 + 0) * 6 * D + 3 * D + 16 * lane; const float* s1 = s0 + 6 * D;
#pragma unroll
            for (int k = 0; k < 8; ++k) { const float lo = __uint_as_float(wu[k] << 16), hi = __uint_as_float(wu[k] & 0xffff0000u);
                a0 += s0[2 * k] * lo + s0[2 * k + 1] * hi; a1 += s1[2 * k] * lo + s1[2 * k + 1] * hi; }
            a0 = wave_sum(a0); a1 = wave_sum(a1);
            if (lane == 0) { b2[(size_t)(l * 2 + 0) * 5632 + rho] = a0; b2[(size_t)(l * 2 + 1) * 5632 + rho] = a1; } } }
    }
}
__device__ __forceinline__ void norm2_phase(const Args& a, LAS unsigned char* lds, int tid, int gw, int NGW, int lane) {
    const float* x = a.out; bf16* hK = (bf16*)(a.ws + WS_HA); bf16* hQ = (bf16*)(a.ws + WS_HQ); float* logf_out = (float*)(a.ws + WS_LOGF);
    const float* mod1 = (const float*)(a.ws + WS_MOD) + 2 * 6 * D; const float* kvmod = (const float*)(a.ws + WS_MOD) + 4 * 6 * D;
    LAS float* wf = (LAS float*)lds;
    { const float* Wf = a.in[13] + 2 * D; for (int k = tid; k < D; k += 512) { const float* src = Wf + (size_t)k * (2 * D + H);
#pragma unroll
        for (int c = 0; c < 16; ++c) wf[c * D + k] = src[c]; } }
    __syncthreads();
    f32x4 ka[4], ks[4], qa[4], qs[4]; int curb = -1; f32x4 vn[4], vn2[4];
    if (gw < M) { const f32x4* xr = (const f32x4*)(x + (size_t)gw * D) + lane;
#pragma unroll
        for (int j = 0; j < 4; ++j) vn[j] = xr[64 * j]; }
    if (gw + NGW < M) { const f32x4* xr = (const f32x4*)(x + (size_t)(gw + NGW) * D) + lane;
#pragma unroll
        for (int j = 0; j < 4; ++j) vn2[j] = xr[64 * j]; }
    for (int m = gw; m < M; m += NGW) {
        const int b = m >> 13;
        if (b != curb) { curb = b;
#pragma unroll
            for (int j = 0; j < 4; ++j) { const int c = 256 * j + 4 * lane;
                ka[j] = *(const f32x4*)(a.in[12] + c) * (1.0f + *(const f32x4*)(kvmod + b * 2 * D + D + c)); ks[j] = *(const f32x4*)(kvmod + b * 2 * D + c);
                qa[j] = *(const f32x4*)(a.in[4] + D + c) * (1.0f + *(const f32x4*)(mod1 + b * 6 * D + D + c)); qs[j] = *(const f32x4*)(mod1 + b * 6 * D + c); } }
        f32x4 v[4]; float s = 0.f;
#pragma unroll
        for (int j = 0; j < 4; ++j) { v[j] = vn[j]; vn[j] = vn2[j]; s += (v[j].x * v[j].x + v[j].y * v[j].y) + (v[j].z * v[j].z + v[j].w * v[j].w); }
        if (m + 2 * NGW < M) { const f32x4* xr = (const f32x4*)(x + (size_t)(m + 2 * NGW) * D) + lane;
#pragma unroll
            for (int j = 0; j < 4; ++j) vn2[j] = xr[64 * j]; }
        const float rstd = 1.0f / sqrtf(wave_sum(s) * (1.f / D) + RMS_EPS);
        unsigned long long* ok = (unsigned long long*)(hK + (size_t)m * D) + lane; unsigned long long* oq = (unsigned long long*)(hQ + (size_t)m * D) + lane;
        f32x4 yk[4];
#pragma unroll
        for (int j = 0; j < 4; ++j) { const f32x4 xn = v[j] * rstd; yk[j] = xn * ka[j] + ks[j]; const f32x4 yq = xn * qa[j] + qs[j];
            ok[64 * j] = (unsigned long long)pk2(yk[j].x, yk[j].y) | ((unsigned long long)pk2(yk[j].z, yk[j].w) << 32);
            oq[64 * j] = (unsigned long long)pk2(yq.x, yq.y) | ((unsigned long long)pk2(yq.z, yq.w) << 32); }
        float part[16];
#pragma unroll
        for (int cg = 0; cg < 4; ++cg) {
#pragma unroll
            for (int c4 = 0; c4 < 4; ++c4) { const int c = 4 * cg + c4; float p = 0.f;
#pragma unroll
                for (int j = 0; j < 4; ++j) { const f32x4 w = *(const LAS f32x4*)(wf + c * D + 256 * j + 4 * lane); p += (yk[j].x * w.x + yk[j].y * w.y) + (yk[j].z * w.z + yk[j].w * w.w); }
                part[c] = p; }
            asm volatile("" ::: "memory");
        }
        float q8[8], q4[4], q2[2], q1;
        { const bool up = (lane & 32) != 0;
#pragma unroll
          for (int c = 0; c < 8; ++c) { const float keep = up ? part[c + 8] : part[c], send = up ? part[c] : part[c + 8]; q8[c] = keep + __shfl_xor(send, 32); } }
        { const bool up = (lane & 16) != 0;
#pragma unroll
          for (int c = 0; c < 4; ++c) { const float keep = up ? q8[c + 4] : q8[c], send = up ? q8[c] : q8[c + 4]; q4[c] = keep + __shfl_xor(send, 16); } }
        { const bool up = (lane & 8) != 0;
#pragma unroll
          for (int c = 0; c < 2; ++c) { const float keep = up ? q4[c + 2] : q4[c], send = up ? q4[c] : q4[c + 2]; q2[c] = keep + __shfl_xor(send, 8); } }
        { const bool up = (lane & 4) != 0; const float keep = up ? q2[1] : q2[0], send = up ? q2[0] : q2[1]; q1 = keep + __shfl_xor(send, 4); }
        q1 += __shfl_xor(q1, 2); q1 += __shfl_xor(q1, 1);
        if ((lane & 3) == 0) { const int c = ((lane >> 5) & 1) * 8 + ((lane >> 4) & 1) * 4 + ((lane >> 3) & 1) * 2 + ((lane >> 2) & 1);
            const float y = q1 + a.in[14][c]; const float lf = -(fmaxf(-y, 0.f) + log1pf(expf(-fabsf(y)))); logf_out[((size_t)b * H + c) * T + (m & (T - 1))] = lf; }
    }
    __syncthreads();
}
__device__ __forceinline__ void scan_seq(const float* src, float* dst, LAS unsigned char* lds, int tid, int lane, int wave) {
    LAS float* wt = (LAS float*)lds;
    f32x4 v[4]; const f32x4* s4 = (const f32x4*)(src + 16 * tid);
#pragma unroll
    for (int j = 0; j < 4; ++j) v[j] = s4[j];
    float run = 0.f;
#pragma unroll
    for (int j = 0; j < 4; ++j) { v[j].x += run; v[j].y += v[j].x; v[j].z += v[j].y; v[j].w += v[j].z; run = v[j].w; }
    float xs = run;
#pragma unroll
    for (int off = 1; off < 64; off <<= 1) { const float y = __shfl_up(xs, off); if (lane >= off) xs += y; }
    if (lane == 63) wt[wave] = xs;
    __syncthreads();
    float woff = 0.f;
#pragma unroll
    for (int w = 0; w < 8; ++w) woff += (w < wave) ? wt[w] : 0.f;
    const float offs = woff + xs - run;
    f32x4* d4 = (f32x4*)(dst + 16 * tid);
#pragma unroll
    for (int j = 0; j < 4; ++j) d4[j] = (v[j] + offs) * LOG2E;
    __syncthreads();
}

#define XB_TMO      128
#define XB_XCNT(j)  (256  + 64 * (j))
#define XB_XSUB(j)  (1280 + 64 * (j))
#define XB_XGEN(j)  (2304 + 64 * (j))
#define XB_TOP      3328
#define XB_TOPGEN   3392
#define XCD_BAR_WORDS 3456
#define XB_SPIN_CAP (1u << 18)

__device__ __forceinline__ unsigned xb_ld(unsigned* p)              { return __hip_atomic_load(p, __ATOMIC_RELAXED, __HIP_MEMORY_SCOPE_AGENT); }
__device__ __forceinline__ unsigned xb_add(unsigned* p, unsigned v) { return __hip_atomic_fetch_add(p, v, __ATOMIC_RELAXED, __HIP_MEMORY_SCOPE_AGENT); }
__device__ __forceinline__ unsigned xb_xcc_id() { return (unsigned)__builtin_amdgcn_s_getreg((3 << 11) | 20) & 0xFu; }
#define XB_SPIN(cond, bar) do { unsigned _sp = 0; while (cond) { __builtin_amdgcn_s_sleep(1); \
    if ((++_sp & 255u) == 0u) { if (xb_ld(&(bar)[XB_TMO])) break; if (_sp > XB_SPIN_CAP) { atomicAdd(&(bar)[XB_TMO], 1u); break; } } } } while (0)

struct XcdBarrier {
    unsigned* bar; unsigned x;
    volatile LAS unsigned* st;
};

__device__ __forceinline__ XcdBarrier xcd_barrier_post(unsigned* bar, volatile LAS unsigned* st) {
    XcdBarrier b; b.bar = bar; b.x = xb_xcc_id(); b.st = st;
    if (threadIdx.x == 0) (void)xb_add(&bar[XB_XCNT(b.x)], 1u);
    return b;
}
__device__ __forceinline__ void xcd_barrier_complete(unsigned* bar, unsigned x, unsigned& nloc, unsigned& nx) {
    const unsigned G = gridDim.x * gridDim.y * gridDim.z;
    unsigned sum, cnt, mine, sp = 0u;
    for (;;) {
        sum = 0u; cnt = 0u; mine = 0u;
#pragma unroll
        for (unsigned j = 0; j < 16; ++j) { const unsigned c = xb_ld(&bar[XB_XCNT(j)]); sum += c; cnt += (c > 0u) ? 1u : 0u; mine = (j == x) ? c : mine; }
        if (sum == G) break;
        __builtin_amdgcn_s_sleep(1);
        if ((++sp & 255u) == 0u) { if (xb_ld(&bar[XB_TMO])) break; if (sp > XB_SPIN_CAP) { atomicAdd(&bar[XB_TMO], 1u); break; } }
    }
    nloc = mine > 0u ? mine : 1u; nx = cnt > 0u ? cnt : 1u;
}

__device__ __forceinline__ void xcd_barrier(const XcdBarrier& b) {
    asm volatile("s_waitcnt vmcnt(0)" ::: "memory");
    __syncthreads();
    if (threadIdx.x == 0) {
        unsigned* bar = b.bar;
        __builtin_amdgcn_s_waitcnt(0);
        unsigned nloc = b.st[0], nx = b.st[1];
        if (nloc == 0u) { xcd_barrier_complete(bar, b.x, nloc, nx); b.st[0] = nloc; b.st[1] = nx; }
        const unsigned old = xb_add(&bar[XB_XSUB(b.x)], 1u);
        const unsigned gen = old / nloc;
        if (old + 1u == (gen + 1u) * nloc) {
            __builtin_amdgcn_fence(__ATOMIC_RELEASE, "agent");
            asm volatile("s_waitcnt vmcnt(0)" ::: "memory");
            const unsigned og = xb_add(&bar[XB_TOP], 1u);
            const unsigned tg = og / nx;
            if (og + 1u == (tg + 1u) * nx) xb_add(&bar[XB_TOPGEN], 1u);
            else XB_SPIN(xb_ld(&bar[XB_TOPGEN]) == tg, bar);
            __builtin_amdgcn_fence(__ATOMIC_ACQUIRE, "agent");
            xb_add(&bar[XB_XGEN(b.x)], 1u);
            asm volatile("s_waitcnt vmcnt(0)" ::: "memory");
        } else {
            XB_SPIN(xb_ld(&bar[XB_XGEN(b.x)]) == gen, bar);
            __builtin_amdgcn_fence(__ATOMIC_ACQUIRE, "agent");
            asm volatile("s_waitcnt vmcnt(0)" ::: "memory");
        }
    }
    __syncthreads();
}


constexpr int CW_BAR = 4096;
constexpr size_t CTL_ZERO_BYTES = 65536 + 2 * 16384 * 4;
__global__ void __launch_bounds__(NWAVES * 64, 2) yoco_fwd(Args args) {
    extern __shared__ __attribute__((aligned(16))) unsigned char lds_raw[];
    LAS unsigned char* lds = (LAS unsigned char*)lds_raw;
    const int tid = threadIdx.x, lane = tid & 63, wave = __builtin_amdgcn_readfirstlane(tid >> 6);
    const int G = gridDim.x, bx = blockIdx.x; const int gw = bx * NWAVES + wave, NGW = G * NWAVES;
    unsigned char* ws = args.ws;
    const float* mod = (const float*)(ws + WS_MOD);
    bf16 *hA = (bf16*)(ws + WS_HA), *hQb = (bf16*)(ws + WS_HQ), *Qb = (bf16*)(ws + WS_Q), *Kb = (bf16*)(ws + WS_K), *Vb = (bf16*)(ws + WS_V), *ACT = (bf16*)(ws + WS_ACT);
    const int lo = args.ph_lo, hi = args.ph_hi;
#define LANE() ({ int l_ = tid & 63; asm volatile("" : "+v"(l_)); l_; })
#ifndef RPT_MASK
#define RPT_MASK 0
#endif
#ifndef PH_MASK
#define PH_MASK 0x7fff
#endif
#define IN(k) (((PH_MASK >> (k)) & 1) && lo <= (k) && (k) < hi)
    { volatile LAS unsigned* st = (volatile LAS unsigned*)(lds + LDS_BYTES - 64); if (tid < 4) st[tid] = 0u; }
    __syncthreads();
    XcdBarrier bar = xcd_barrier_post((unsigned*)(ws + WS_CTL) + CW_BAR, (volatile LAS unsigned*)(lds + LDS_BYTES - 64));
    if (args.ph_hi > 1000) cg::this_grid().sync();
#define SEAM(k) do { if (IN(k) && (k) + 1 < hi) xcd_barrier(bar); } while (0)
    if (IN(0)) { for (int rep_ = 0; rep_ <= ((RPT_MASK >> 0) & 1); ++rep_) { if (rep_) xcd_barrier(bar); prologue(args, lds, tid, LANE(), wave, G); } } SEAM(0);
    if (IN(1)) { for (int rep_ = 0; rep_ <= ((RPT_MASK >> 1) & 1); ++rep_) { if (rep_) xcd_barrier(bar); norm_phase(args.in[0], hA, args.in[4], mod, mod + D, 6 * D, gw, NGW, LANE()); bias2_phase(ws, gw, NGW, LANE(), 0); } } SEAM(1);
    if (IN(2)) { for (int rep_ = 0; rep_ <= ((RPT_MASK >> 2) & 1); ++rep_) { if (rep_) xcd_barrier(bar); pg8::Gemm g{hA, (const bf16*)(ws + WS_WQKV), M, 3 * D, D}; pg8::StaticOrder S; S.init(M, 3 * D, G, bx);
        pg8::EpiQKV E{Qb, (size_t)(WS_K - WS_Q) / 2, QSCALE}; pg8::gemm_phase<pg8::EpiQKV, pg8::StaticOrder, true, true>(lds, g, S, E); } } SEAM(2);
    if (IN(3)) { for (int rep_ = 0; rep_ <= ((RPT_MASK >> 3) & 1); ++rep_) { if (rep_) xcd_barrier(bar); att::sb_wave_phase((ALAS char*)lds, Qb, Kb, Vb, hA, G, bx); } } SEAM(3);
    if (IN(4)) { for (int rep_ = 0; rep_ <= ((RPT_MASK >> 4) & 1); ++rep_) { if (rep_) xcd_barrier(bar); pg8::Gemm g{hA, (const bf16*)(ws + WS_WO0), M, D, D}; pg8::StaticOrder S; S.init(M, D, G, bx);
        pg8::EpiResN E{args.in[0], args.out, mod + 2 * D, 6 * D, hQb, args.in[5], mod + 4 * D, (float*)(ws + WS_PART)}; pg8::gemm_phase<pg8::EpiResN, pg8::StaticOrder, true, true>(lds, g, S, E); } } SEAM(4);
    if (IN(6)) { for (int rep_ = 0; rep_ <= ((RPT_MASK >> 6) & 1); ++rep_) { if (rep_) xcd_barrier(bar); pg8::Gemm g{hQb, (const bf16*)(ws + WS_WIN0), M, 2 * FF, D}; const unsigned ldsx = (unsigned)(uintptr_t)(lds + RING_BYTES);
        pg8::SwiOrder S{{}, (const float*)(ws + WS_PART), (const float*)(ws + WS_BIAS2), ldsx, 0}; S.so.init(M, 2 * FF, G, bx);
        pg8::EpiSwiGLU E{ACT, ldsx, RMS_EPS, 0}; pg8::gemm_phase<pg8::EpiSwiGLU, pg8::SwiOrder, true, true>(lds, g, S, E);
        if (G == 256) { if (bx >= 128) transpose_weights(args, lds, LANE(), (bx - 128) * NWAVES + wave, 128 * NWAVES, 4, 9); } else transpose_weights(args, lds, LANE(), gw, NGW, 4, 9); } } SEAM(6);
    if (IN(7)) { for (int rep_ = 0; rep_ <= ((RPT_MASK >> 7) & 1); ++rep_) { if (rep_) xcd_barrier(bar); pg8::Gemm g{ACT, (const bf16*)(ws + WS_WDN0), M, D, FF}; pg8::StaticOrder S; S.init(M, D, G, bx);
        pg8::EpiRes E{args.out, args.out, mod + 5 * D, 6 * D}; pg8::gemm_phase<pg8::EpiRes, pg8::StaticOrder, true, true>(lds, g, S, E); } } SEAM(7);
    if (IN(8)) { for (int rep_ = 0; rep_ <= ((RPT_MASK >> 8) & 1); ++rep_) { if (rep_) xcd_barrier(bar); norm2_phase(args, lds, tid, gw, NGW, LANE()); bias2_phase(ws, gw, NGW, LANE(), 1); } } SEAM(8);
    if (IN(9)) { for (int rep_ = 0; rep_ <= ((RPT_MASK >> 9) & 1); ++rep_) { if (rep_) xcd_barrier(bar);
        if (bx < BATCH * H) scan_seq((const float*)(ws + WS_LOGF) + (size_t)bx * T, (float*)(ws + WS_FC) + (size_t)bx * T, lds, tid, LANE(), wave);
        pg8::Gemm g{hA, (const bf16*)(ws + WS_WKV), 2 * M, 3 * D, D}; pg8::StackOrder S{G, bx};
        pg8::EpiKVQ E{Kb, Vb, Qb, args.in[15], args.in[17], QSCALE, RMS_EPS}; pg8::gemm_phase<pg8::EpiKVQ, pg8::StackOrder, true, true>(lds, g, S, E); } } SEAM(9);
    if (IN(10)) { for (int rep_ = 0; rep_ <= ((RPT_MASK >> 10) & 1); ++rep_) { if (rep_) xcd_barrier(bar); att::attn_phase<1>((ALAS char*)lds, Qb, Kb, Vb, hA, (const float*)(ws + WS_FC), args.in[15], (unsigned*)(ws + WS_CTL) + 64 + 128 * rep_); } } SEAM(10);
    if (IN(11)) { for (int rep_ = 0; rep_ <= ((RPT_MASK >> 11) & 1); ++rep_) { if (rep_) xcd_barrier(bar); pg8::Gemm g{hA, (const bf16*)(ws + WS_WO1), M, D, D}; pg8::StaticOrder S; S.init(M, D, G, bx);
        pg8::EpiResN E{args.out, args.out, mod + 2 * 6 * D + 2 * D, 6 * D, hQb, args.in[5] + D, mod + 2 * 6 * D + 4 * D, (float*)(ws + WS_PART) + M}; pg8::gemm_phase<pg8::EpiResN, pg8::StaticOrder, true, true>(lds, g, S, E); } } SEAM(11);
    if (IN(13)) { for (int rep_ = 0; rep_ <= ((RPT_MASK >> 13) & 1); ++rep_) { if (rep_) xcd_barrier(bar); pg8::Gemm g{hQb, (const bf16*)(ws + WS_WIN1), M, 2 * FF, D}; const unsigned ldsx = (unsigned)(uintptr_t)(lds + RING_BYTES);
        pg8::SwiOrder S{{}, (const float*)(ws + WS_PART) + M, (const float*)(ws + WS_BIAS2) + 2 * 5632, ldsx, 0}; S.so.init(M, 2 * FF, G, bx);
        pg8::EpiSwiGLU E{ACT, ldsx, RMS_EPS, 0}; pg8::gemm_phase<pg8::EpiSwiGLU, pg8::SwiOrder, true, true>(lds, g, S, E); } } SEAM(13);
    if (IN(14)) { for (int rep_ = 0; rep_ <= ((RPT_MASK >> 14) & 1); ++rep_) { if (rep_) xcd_barrier(bar); pg8::Gemm g{ACT, (const bf16*)(ws + WS_WDN1), M, D, FF}; pg8::StaticOrder S; S.init(M, D, G, bx);
        pg8::EpiRes E{args.out, args.out, mod + 2 * 6 * D + 5 * D, 6 * D}; pg8::gemm_phase<pg8::EpiRes, pg8::StaticOrder, true, true>(lds, g, S, E); } }
#undef IN
#undef SEAM
}

extern "C" void kernel_launch(void* const* d_in, const int* in_sizes, int n_in, void* d_out, int out_size, void* d_ws, size_t ws_size, hipStream_t stream) {
    static int grid = 0;
    if (grid == 0) {
        if (n_in != 19 || out_size != M * D || ws_size < WS_END) { fprintf(stderr, "kernel_launch: unexpected shapes (n_in %d, out %d, ws %zu)\n", n_in, out_size, ws_size); grid = -1; return; }
        int dev = 0, cus = 0, per_cu = 0;
        (void)hipGetDevice(&dev); (void)hipDeviceGetAttribute(&cus, hipDeviceAttributeMultiprocessorCount, dev);
        if (hipFuncSetAttribute((const void*)yoco_fwd, hipFuncAttributeMaxDynamicSharedMemorySize, LDS_BYTES) != hipSuccess) { fprintf(stderr, "kernel_launch: hipFuncSetAttribute failed\n"); grid = -1; return; }
        if (hipOccupancyMaxActiveBlocksPerMultiprocessor(&per_cu, (const void*)yoco_fwd, NWAVES * 64, LDS_BYTES) != hipSuccess || per_cu < 1) { fprintf(stderr, "kernel_launch: occupancy query says %d\n", per_cu); per_cu = 1; }
        (void)hipGetLastError();
        grid = cus;
    }
    if (grid < 0) return;
    if (hipMemsetAsync((char*)d_ws + WS_CTL, 0, CTL_ZERO_BYTES, stream) != hipSuccess) { fprintf(stderr, "kernel_launch: memset failed\n"); return; }
    Args a{};
    for (int i = 0; i < 19; ++i) a.in[i] = (const float*)d_in[i];
    a.out = (float*)d_out; a.ws = (unsigned char*)d_ws;
#if MK_PER_PHASE
    for (int p = 0; p < N_PHASES; ++p) { a.ph_lo = p; a.ph_hi = p + 1; hipLaunchKernelGGL(yoco_fwd, dim3(grid), dim3(NWAVES * 64), LDS_BYTES, stream, a); }
#else
    a.ph_lo = 0; a.ph_hi = N_PHASES;
    void* kargs[] = {&a};
    const hipError_t e = hipLaunchCooperativeKernel((const void*)yoco_fwd, dim3(grid), dim3(NWAVES * 64), kargs, LDS_BYTES, stream);
    if (e != hipSuccess) fprintf(stderr, "kernel_launch: cooperative launch failed: %s (grid %d)\n", hipGetErrorString(e), grid);
#endif
}
```
